# Optimizing an MI355X kernel written in HIP

```python
import math
import jax, jax.numpy as jnp
from jax import lax
import numpy as np

D_MODEL = 2048
BATCH = 1
SEQ = 8192
DEPTH = 2

N_META = 16
D_MIX = 2 * D_MODEL
EPS = 1e-6
POOL_WIDTH = D_MIX // 4
POOL_WINDOWS = (2, 4, 8, 16)
POOL_GROUP = POOL_WIDTH // 4
SSD_WIDTH = D_MIX // 2
SSD_HEADDIM = 64
SSD_HEADS = SSD_WIDTH // SSD_HEADDIM
SSD_GROUPS = 4
SSD_STATE = 128
SSD_CONV = 4
SSD_CHUNK = 128
SSD_CONV_DIM = SSD_WIDTH + 2 * SSD_GROUPS * SSD_STATE
ATTN_WIDTH = D_MIX // 4
ATTN_HEADDIM = 128
ATTN_HEADS = ATTN_WIDTH // ATTN_HEADDIM
ATTN_KV_HEADS = 2
IDX_HEADS = 16
IDX_HEADDIM = 64
INDEX_TOPK = 256
Q_BLOCK = 128
ROPE_THETA = 500000.0
ROPE_FRACTION = 4

SPLIT_SIZES = (POOL_WIDTH, POOL_WIDTH,
               SSD_WIDTH, SSD_CONV_DIM, SSD_HEADS,
               ATTN_HEADS * ATTN_HEADDIM,
               ATTN_KV_HEADS * ATTN_HEADDIM,
               ATTN_KV_HEADS * ATTN_HEADDIM,
               ATTN_WIDTH,
               IDX_HEADS * IDX_HEADDIM, IDX_HEADDIM, IDX_HEADS)
D_IN = sum(SPLIT_SIZES)

kernel_name = 'hybrid_pool_ssd_dsa_block'


def rmsnorm(x, w):
    xf = x.astype(jnp.float32)
    y = xf * lax.rsqrt(jnp.mean(xf * xf, axis=-1, keepdims=True) + EPS)
    return (y * w.astype(jnp.float32)).astype(x.dtype)


def rope_partial(x, pos):
    d = x.shape[-1]
    rot = d // ROPE_FRACTION
    half = rot // 2
    inv = jnp.power(jnp.float32(ROPE_THETA), -(jnp.arange(half, dtype=jnp.float32) * 2.0 / rot))
    ang = pos.astype(jnp.float32)[:, None] * inv[None, :]
    cos = jnp.cos(ang)[:, None, :]
    sin = jnp.sin(ang)[:, None, :]
    xf = x.astype(jnp.float32)
    x1 = xf[..., :half]
    x2 = xf[..., half:rot]
    out = jnp.concatenate([x1 * cos - x2 * sin, x2 * cos + x1 * sin, xf[..., rot:]], axis=-1)
    return out.astype(x.dtype)


def pool_mixer(v, pool_w, pool_scale):
    b, t, _ = v.shape
    vf = v.astype(jnp.float32)
    cs0 = jnp.pad(jnp.cumsum(vf, axis=1), ((0, 0), (1, 0), (0, 0)))
    hi = jnp.arange(1, t + 1)
    groups = []
    for g, w in enumerate(POOL_WINDOWS):
        lo = jnp.maximum(hi - w, 0)
        cnt = (hi - lo).astype(jnp.float32)[None, :, None]
        sl = slice(g * POOL_GROUP, (g + 1) * POOL_GROUP)
        groups.append((cs0[:, hi, sl] - cs0[:, lo, sl]) / cnt)
    pooled = jnp.stack(groups, axis=2)
    y = (pooled - vf.reshape(b, t, len(POOL_WINDOWS), POOL_GROUP)).astype(v.dtype)
    y = jnp.einsum('btgc,gcd->btgd', y, pool_w).reshape(b, t, POOL_WIDTH)
    return y * pool_scale


def causal_dwconv(x, w, bias):
    k = w.shape[0]
    t = x.shape[1]
    xp = jnp.pad(x, ((0, 0), (k - 1, 0), (0, 0)))
    out = bias
    for i in range(k):
        out = out + xp[:, i:i + t] * w[i]
    return out


def segsum_exp(a):
    l = a.shape[-1]
    cs = jnp.cumsum(a, axis=-1)
    diff = cs[..., :, None] - cs[..., None, :]
    mask = jnp.tril(jnp.ones((l, l), dtype=bool))
    return jnp.where(mask, jnp.exp(jnp.where(mask, diff, 0.0)), 0.0)


def ssd_chunked(x, dt, a, bm, cm):
    b, tp, h, p = x.shape
    g, n = bm.shape[2], bm.shape[3]
    r = h // g
    c = tp // SSD_CHUNK
    l = SSD_CHUNK
    x = x.reshape(b, c, l, g, r, p)
    dt = dt.reshape(b, c, l, g, r)
    bm = bm.reshape(b, c, l, g, n)
    cm = cm.reshape(b, c, l, g, n)
    xdt = x * dt[..., None]
    da = dt.transpose(0, 1, 3, 4, 2) * a.reshape(g, r)[None, None, :, :, None]
    cs = jnp.cumsum(da, axis=-1)
    lm = segsum_exp(da)
    cb = jnp.einsum('bclgn,bcsgn->bcgls', cm, bm)
    y_diag = jnp.einsum('bcgrls,bcsgrp->bclgrp', cb[:, :, :, None] * lm, xdt)
    decay_states = jnp.exp(cs[..., -1:] - cs)
    states = jnp.einsum('bcsgn,bcgrs,bcsgrp->bcgrpn', bm, decay_states, xdt)
    chunk_decay = jnp.exp(cs[..., -1])

    def step(hstate, inp):
        dec, st = inp
        return hstate * dec[..., None, None] + st, hstate

    h0 = jnp.zeros((b, g, r, p, n), jnp.float32)
    _, prev = lax.scan(step, h0, (jnp.swapaxes(chunk_decay, 0, 1), jnp.swapaxes(states, 0, 1)))
    prev = jnp.swapaxes(prev, 0, 1)
    y_off = jnp.einsum('bclgn,bcgrpn,bcgrl->bclgrp', cm, prev, jnp.exp(cs))
    return (y_diag + y_off).reshape(b, tp, h, p)


def pad_front(a, n):
    return jnp.pad(a, ((0, 0), (n, 0)) + ((0, 0),) * (a.ndim - 2))


def ssd_mixer(xbc_raw, z, dt_raw, conv_w, conv_b, dt_bias, a_log, d_skip, norm_w):
    b, t, _ = xbc_raw.shape
    xbc = jax.nn.silu(causal_dwconv(xbc_raw, conv_w, conv_b)).astype(jnp.float32)
    xs = xbc[..., :SSD_WIDTH].reshape(b, t, SSD_HEADS, SSD_HEADDIM)
    bm = xbc[..., SSD_WIDTH:SSD_WIDTH + SSD_GROUPS * SSD_STATE].reshape(b, t, SSD_GROUPS, SSD_STATE)
    cm = xbc[..., SSD_WIDTH + SSD_GROUPS * SSD_STATE:].reshape(b, t, SSD_GROUPS, SSD_STATE)
    dt = jax.nn.softplus(dt_raw.astype(jnp.float32) + dt_bias.astype(jnp.float32))
    a = -jnp.exp(a_log.astype(jnp.float32))
    pad = (SSD_CHUNK - N_META % SSD_CHUNK) % SSD_CHUNK
    y = ssd_chunked(pad_front(xs, pad), pad_front(dt, pad), a,
                    pad_front(bm, pad), pad_front(cm, pad))[:, pad:]
    y = y + d_skip.astype(jnp.float32)[:, None] * xs
    yg = (y.reshape(b, t, SSD_WIDTH) * jax.nn.silu(z.astype(jnp.float32))).reshape(b, t, SSD_GROUPS, -1)
    yg = yg * lax.rsqrt(jnp.mean(yg * yg, axis=-1, keepdims=True) + EPS)
    return (yg.reshape(b, t, SSD_WIDTH) * norm_w.astype(jnp.float32)).astype(xbc_raw.dtype)


def dsa_attention(q, k, v, q_idx, k_idx, w_idx, topk):
    b, t, h, d = q.shape
    kv = k.shape[2]
    rep = h // kv
    nb = -(-t // Q_BLOCK)
    tq = nb * Q_BLOCK
    scale = d ** -0.5
    idx_scale = (IDX_HEADDIM ** -0.5) * (IDX_HEADS ** -0.5)

    def blocks(a):
        a = jnp.pad(a, ((0, 0), (0, tq - t)) + ((0, 0),) * (a.ndim - 2))
        return jnp.swapaxes(a.reshape((b, nb, Q_BLOCK) + a.shape[2:]), 0, 1)

    key_pos = jnp.arange(t)
    k_idx_f = k_idx.astype(jnp.float32)
    gather = jax.vmap(lambda arr, ix: arr[ix])

    def one_block(args):
        i, qi, qii, wi = args
        q_pos = i * Q_BLOCK + jnp.arange(Q_BLOCK)
        s = jax.nn.relu(jnp.einsum('bqhd,bsd->bqhs', qii.astype(jnp.float32), k_idx_f))
        score = jnp.einsum('bqhs,bqh->bqs', s, wi.astype(jnp.float32)) * idx_scale
        causal = key_pos[None, :] <= q_pos[:, None]
        score = jnp.where(causal[None], score, -jnp.inf)
        _, sel = lax.top_k(score, topk)
        valid = sel <= q_pos[None, :, None]
        ks = gather(k, sel).astype(jnp.float32)
        vs = gather(v, sel).astype(jnp.float32)
        qg = qi.reshape(b, Q_BLOCK, kv, rep, d).astype(jnp.float32)
        logits = jnp.einsum('bqgrd,bqkgd->bqgrk', qg, ks) * scale
        logits = jnp.where(valid[:, :, None, None, :], logits, -jnp.inf)
        p = jax.nn.softmax(logits, axis=-1)
        o = jnp.einsum('bqgrk,bqkgd->bqgrd', p, vs)
        return o.reshape(b, Q_BLOCK, h, d).astype(q.dtype)

    out = lax.map(one_block, (jnp.arange(nb), blocks(q), blocks(q_idx), blocks(w_idx)))
    return jnp.swapaxes(out, 0, 1).reshape(b, tq, h, d)[:, :t]


def hybrid_layer(h, pos, topk, pre_w, post_w, w_in, pool_w, pool_scale, conv_w, conv_b,
                 dt_bias, a_log, d_skip, ssd_norm_w, w_out):
    b, t, _ = h.shape
    u = rmsnorm(h, pre_w)
    proj = jnp.einsum('btd,de->bte', u, w_in)
    offsets = np.cumsum(SPLIT_SIZES)[:-1].tolist()
    (pool_v, pool_g, ssd_z, ssd_xbc, ssd_dt, a_q, a_k, a_v, a_g,
     i_q, i_k, i_w) = jnp.split(proj, offsets, axis=-1)
    pool_out = jax.nn.silu(pool_g) * pool_mixer(pool_v, pool_w, pool_scale)
    ssd_out = ssd_mixer(ssd_xbc, ssd_z, ssd_dt, conv_w, conv_b, dt_bias, a_log, d_skip, ssd_norm_w)
    q = rope_partial(a_q.reshape(b, t, ATTN_HEADS, ATTN_HEADDIM), pos)
    k = rope_partial(a_k.reshape(b, t, ATTN_KV_HEADS, ATTN_HEADDIM), pos)
    v = a_v.reshape(b, t, ATTN_KV_HEADS, ATTN_HEADDIM)
    qi = rope_partial(i_q.reshape(b, t, IDX_HEADS, IDX_HEADDIM), pos)
    ki = rope_partial(i_k.reshape(b, t, 1, IDX_HEADDIM), pos)[:, :, 0]
    attn = dsa_attention(q, k, v, qi, ki, i_w, topk).reshape(b, t, ATTN_WIDTH)
    attn_out = jax.nn.silu(a_g) * attn
    mix = jnp.concatenate([pool_out, ssd_out, attn_out], axis=-1)
    out = jnp.einsum('bte,ed->btd', mix, w_out)
    return h + rmsnorm(out, post_w)


def setup_inputs(seed: int = 0) -> dict:
    key = jax.random.key(seed)
    ks = jax.random.split(key, 14)
    f = jnp.float32
    x = jax.random.normal(ks[0], (BATCH, SEQ, D_MODEL), f)
    meta_tokens = jax.random.normal(ks[1], (N_META, D_MODEL), f)
    pre_norm_w = 1.0 + 0.1 * jax.random.normal(ks[2], (DEPTH, D_MODEL), f)
    post_norm_w = 1.0 + 0.1 * jax.random.normal(ks[3], (DEPTH, D_MODEL), f)
    w_in = jax.random.normal(ks[4], (DEPTH, D_MODEL, D_IN), f) * D_MODEL ** -0.5
    pool_w = jax.random.normal(ks[5], (DEPTH, len(POOL_WINDOWS), POOL_GROUP, POOL_GROUP), f) * POOL_GROUP ** -0.5
    pool_scale = 1.0 + 0.1 * jax.random.normal(ks[6], (DEPTH, POOL_WIDTH), f)
    conv_w = jax.random.normal(ks[7], (DEPTH, SSD_CONV, SSD_CONV_DIM), f) * SSD_CONV ** -0.5
    conv_b = 0.01 * jax.random.normal(ks[8], (DEPTH, SSD_CONV_DIM), f)
    dt0 = jnp.exp(jax.random.uniform(ks[9], (DEPTH, SSD_HEADS), f)
                  * (math.log(0.1) - math.log(0.001)) + math.log(0.001))
    dt_bias = dt0 + jnp.log(-jnp.expm1(-dt0))
    a_log = jnp.log(jax.random.uniform(ks[10], (DEPTH, SSD_HEADS), f, minval=1.0, maxval=16.0))
    d_skip = 1.0 + 0.1 * jax.random.normal(ks[11], (DEPTH, SSD_HEADS), f)
    ssd_norm_w = 1.0 + 0.1 * jax.random.normal(ks[12], (DEPTH, SSD_WIDTH), f)
    w_out = jax.random.normal(ks[13], (DEPTH, D_MIX, D_MODEL), f) * D_MIX ** -0.5
    return {'x': x, 'meta_tokens': meta_tokens, 'pre_norm_w': pre_norm_w, 'post_norm_w': post_norm_w,
            'w_in': w_in, 'pool_w': pool_w, 'pool_scale': pool_scale, 'conv_w': conv_w, 'conv_b': conv_b,
            'dt_bias': dt_bias, 'a_log': a_log, 'd_skip': d_skip, 'ssd_norm_w': ssd_norm_w, 'w_out': w_out}


def reference(x, meta_tokens, pre_norm_w, post_norm_w, w_in, pool_w, pool_scale, conv_w, conv_b,
              dt_bias, a_log, d_skip, ssd_norm_w, w_out):
    b, s, d = x.shape
    meta = jnp.broadcast_to(meta_tokens.astype(x.dtype)[None], (b, N_META, d))
    h = jnp.concatenate([meta, x], axis=1)
    pos = jnp.arange(s + N_META)
    topk = min(INDEX_TOPK, s // 4)
    for l in range(DEPTH):
        h = hybrid_layer(h, pos, topk, pre_norm_w[l], post_norm_w[l], w_in[l], pool_w[l], pool_scale[l],
                         conv_w[l], conv_b[l], dt_bias[l], a_log[l], d_skip[l], ssd_norm_w[l], w_out[l])
    return h[:, N_META:]
```

```cpp
#include <hip/hip_runtime.h>
#include <hip/hip_cooperative_groups.h>
#include <cstdio>
#include <cstdint>
#include <cmath>
namespace cg = cooperative_groups;

typedef unsigned short bf16_t;
typedef short bf16x8 __attribute__((ext_vector_type(8)));
typedef float f32x4 __attribute__((ext_vector_type(4)));
typedef float f32x16 __attribute__((ext_vector_type(16)));
typedef unsigned u32x4 __attribute__((ext_vector_type(4)));
typedef unsigned u32x2 __attribute__((ext_vector_type(2)));
#define LAS __attribute__((address_space(3)))
#define FI __device__ __forceinline__

constexpr int MR = 8448;
constexpr int ROW0 = 240;
constexpr int NTOK = 8208;
constexpr int DM = 2048;
constexpr int NP = 11008;
constexpr int DMIX = 4096;
constexpr int NCH = 65;
constexpr float EPS = 1e-6f;
constexpr int LDS_BYTES = 147456;

constexpr size_t OFF_CTL = 0;
constexpr size_t OFF_BAR = 4096;
constexpr size_t CTL_BYTES = 32768;
constexpr size_t OFF_WIN = CTL_BYTES;
constexpr size_t OFF_WOUT = OFF_WIN + (size_t)NP * DM * 2;
constexpr size_t OFF_PWT = OFF_WOUT + (size_t)DM * DMIX * 2;
constexpr size_t OFF_ROPEA = OFF_PWT + (size_t)2 * 4 * 65536 * 2;
constexpr size_t OFF_ROPEI = OFF_ROPEA + (size_t)MR * 16 * 4 * 2;
constexpr size_t OFF_H = OFF_ROPEI + (size_t)MR * 8 * 4 * 2;
constexpr size_t OFF_U = OFF_H + (size_t)MR * DM * 4;
constexpr size_t OFF_PG = OFF_U + (size_t)MR * DM * 2;
constexpr size_t OFF_ZS = OFF_PG + (size_t)MR * 1024 * 2;
constexpr size_t OFF_XBC = OFF_ZS + (size_t)MR * 2048 * 2;
constexpr size_t OFF_PV = OFF_XBC + (size_t)MR * 3072 * 2;
constexpr size_t OFF_MIX = OFF_XBC;
constexpr size_t OFF_DT = OFF_PV + (size_t)MR * 1024 * 2;
constexpr size_t OFF_Q = OFF_DT + (size_t)MR * 32 * 4;
constexpr size_t OFF_K = OFF_Q + (size_t)MR * 1024 * 2;
constexpr size_t OFF_V = OFF_K + (size_t)MR * 256 * 2;
constexpr size_t OFF_AG = OFF_V + (size_t)MR * 256 * 2;
constexpr size_t OFF_IQ = OFF_AG + (size_t)MR * 1024 * 2;
constexpr size_t OFF_IK = OFF_IQ + (size_t)MR * 1024 * 2;
constexpr size_t OFF_IW = OFF_IK + (size_t)MR * 64 * 2;
constexpr size_t OFF_XS = OFF_IW + (size_t)MR * 16 * 4;
constexpr size_t OFF_CM = OFF_XS + (size_t)MR * 2048 * 2;
constexpr size_t OFF_CSB = OFF_CM + (size_t)MR * 512 * 2;
constexpr size_t OFF_YD = OFF_CSB + (size_t)MR * 32 * 4;
constexpr size_t OFF_OUT = OFF_YD;
constexpr size_t OFF_HS = OFF_YD + (size_t)MR * 2048 * 2;
static_assert((size_t)NCH * 32 * 64 * 128 * 2 <= (size_t)MR * 2048 * 2, "HS fits behind the bf16 y_diag");
constexpr size_t OFF_ST = OFF_YD + (size_t)MR * 2048 * 4;
constexpr size_t OFF_CD = OFF_ST + (size_t)NCH * 32 * 64 * 128 * 4;
constexpr size_t OFF_SC = OFF_CD + 8448;
constexpr size_t OFF_IDX = OFF_SC + (size_t)1089 * 256 * 128 * 4;
constexpr size_t OFF_CNT = OFF_IDX + (size_t)MR * 256 * 4;
constexpr size_t WS_END = OFF_CNT + (size_t)MR * 4;
static_assert(OFF_PV + (size_t)MR * 1024 * 2 - OFF_XBC == (size_t)MR * DMIX * 2, "MIX alias");
static_assert(WS_END <= 711983104ull, "workspace");

struct Args { const float* in[14]; float* out; unsigned char* ws; };
__device__ __forceinline__ Args load_args() {
#if defined(__HIP_DEVICE_COMPILE__)
    const __attribute__((address_space(4))) Args* p = (const __attribute__((address_space(4))) Args*)__builtin_amdgcn_kernarg_segment_ptr();
    asm volatile("" : "+s"(p));
    Args r;
#pragma unroll
    for (int i = 0; i < 14; ++i) r.in[i] = p->in[i];
    r.out = p->out; r.ws = p->ws;
    return r;
#else
    return Args{};
#endif
}

FI unsigned cvt_pk_bf16(float lo, float hi) { unsigned r; asm volatile("v_cvt_pk_bf16_f32 %0, %1, %2" : "=v"(r) : "v"(lo), "v"(hi)); return r; }
FI bf16_t f2bf(float f) { return (bf16_t)(cvt_pk_bf16(f, 0.f) & 0xffffu); }
FI float bf2f(bf16_t h) { return __uint_as_float((unsigned)h << 16); }
FI float bflo(unsigned w) { return __uint_as_float(w << 16); }
FI float bfhi(unsigned w) { return __uint_as_float(w & 0xffff0000u); }
FI float silu_f(float x) { return x / (1.f + __expf(-x)); }
FI float wave_sum(float v) {
#pragma unroll
    for (int o = 1; o < 64; o <<= 1) v += __shfl_xor(v, o);
    return v;
}
FI void unpack8(u32x4 w, float* o) { o[0] = bflo(w.x); o[1] = bfhi(w.x); o[2] = bflo(w.y); o[3] = bfhi(w.y); o[4] = bflo(w.z); o[5] = bfhi(w.z); o[6] = bflo(w.w); o[7] = bfhi(w.w); }
FI u32x4 pack8(const float* v) { u32x4 w; w.x = cvt_pk_bf16(v[0], v[1]); w.y = cvt_pk_bf16(v[2], v[3]); w.z = cvt_pk_bf16(v[4], v[5]); w.w = cvt_pk_bf16(v[6], v[7]); return w; }
FI f32x16 mfma32(bf16x8 a, bf16x8 b, f32x16 c) { return __builtin_amdgcn_mfma_f32_32x32x16_bf16(a, b, c, 0, 0, 0); }
FI f32x4 mfma16(bf16x8 a, bf16x8 b, f32x4 c) { return __builtin_amdgcn_mfma_f32_16x16x32_bf16(a, b, c, 0, 0, 0); }

FI int tid_l() { int t = threadIdx.x; asm volatile("" : "+v"(t)); return t; }
FI int next_item(unsigned* ctr, LAS int* slot, int& nxt, int total) {
    __syncthreads();
    if (tid_l() == 0) *slot = (int)atomicAdd(ctr, 1u);
    __syncthreads();
    return *slot;
}
FI int wave_fetch(unsigned* ctr, int lane) { int v = 0; if (lane == 0) v = (int)atomicAdd(ctr, 1u); return v; }
FI int first_item(unsigned* ctr) { return 0; }

namespace pg8 {
constexpr int BM = 256, BK = 64, HALF = 128, HTB = HALF * BK * 2, STAGE_BYTES = 8 * HTB, NXCD = 8, WGM = 8;
FI int lds_byte(int r, int c) { const int st = (r >> 4) * 2 + (c >> 5), rr = r & 15, cc = c & 31, ob = rr * 64 + cc * 2; return st * 1024 + (ob ^ (((ob >> 9) & 1) << 5)); }
FI void stage_rc(int b, int& R, int& C) { const int st = b / 1024, sb = b % 1024, swz = sb ^ (((sb >> 9) & 1) << 5); R = (st >> 1) * 16 + swz / 64; C = (st & 1) * 32 + (swz % 64) / 2; }
FI int perm32(int rho) { const int n = rho >> 4, i = rho & 15; return 8 * (i >> 2) + 4 * n + (i & 3); }
struct Unit { int pm, pn; };
struct Gemm { const bf16_t* A; const bf16_t* Bt; int M, N, K; };

struct StaticOrder {
    int nM, nN, nwg, G, c, K;
    FI void init(int M, int N, int K_, int G_, int c_) { nM = M / BM; nN = N / BM; nwg = nM * nN; G = G_; c = c_; K = K_; }
    FI bool next(int i, Unit& u) const {
        const long L = (long)i * G + c; if (L >= nwg) return false;
        int wgid = (int)L; { const int q = nwg / NXCD, r = nwg % NXCD, xcd = wgid % NXCD, off = wgid / NXCD; wgid = (xcd < r ? xcd * (q + 1) : r * (q + 1) + (xcd - r) * q) + off; }
        const int nig = WGM * nN, gid = wgid / nig, fm = gid * WGM, gsz = (nM - fm) < WGM ? (nM - fm) : WGM;
        u.pm = fm + ((wgid % nig) % gsz); u.pn = (wgid % nig) / gsz; return true;
    }
    FI size_t aoff(const Unit& u) const { return (size_t)u.pm * 512 * K; }
    FI size_t boff(const Unit& u) const { return (size_t)u.pn * 512 * K; }
};
struct PoolOrder {
    int G, c;
    FI bool next(int i, Unit& u) const { const int L = i * G + c; if (L >= 132) return false; u.pm = L; u.pn = 0; return true; }
    FI size_t aoff(const Unit& u) const { return (size_t)u.pm * 512 * 256; }
    FI size_t boff(const Unit& u) const { return (size_t)(u.pm / 33) * 65536 * 2; }
};

template <class Epi, class Sched, bool ALIGN_EPI = false, bool SP2 = false>
FI void gemm_phase(LAS unsigned char* lds, const Gemm g, const Sched& S, const Epi& E) {
    const int tid = tid_l(), wid = __builtin_amdgcn_readfirstlane(tid >> 6), lane = tid & 63, wr = wid >> 2, wc = wid & 3, fr = lane & 15, fq = lane >> 4;
    const int K = g.K, nt = K / BK;
    unsigned voffA[2], voffB[2];
#pragma unroll
    for (int i = 0; i < 2; ++i) { int R, C; stage_rc(tid * 16 + i * 8192, R, C); const int Rb = Epi::PERM ? ((R & ~31) + perm32(R & 31)) : R;
        voffA[i] = (unsigned)(R * K + C) * 2u; voffB[i] = (unsigned)(Rb * K + C) * 2u; }
    const size_t kstep = (size_t)(BK * 2);
    const size_t hstep = (size_t)HALF * K * 2;
    const unsigned ldsw = (unsigned)wid * 1024u;
    const int aoff = lds_byte(wr * 64 + fr, fq * 8), boff = lds_byte(wc * 32 + fr, fq * 8);
#define PG8_SA(b, h) (((b) * 2 + (h)) * HTB)
#define PG8_SB(b, h) ((4 + (b) * 2 + (h)) * HTB)
#define PG8_STAGE(bufoff, gbase, voff) do { _Pragma("unroll") for (int _i = 0; _i < 2; ++_i) \
        __builtin_amdgcn_global_load_lds((const unsigned*)((const char*)(gbase) + (voff)[_i]), (LAS unsigned*)(lds + (bufoff) + ldsw + _i * 8192), 16, 0, 0); } while (0)
#define PG8_LDA(dst, b, h) do { _Pragma("unroll") for (int m = 0; m < 4; ++m) _Pragma("unroll") for (int k = 0; k < 2; ++k) dst[m][k] = *(const LAS bf16x8*)(lds + PG8_SA(b, h) + aoff + m * 2048 + k * 1024); } while (0)
#define PG8_LDB(dst, b, h) do { _Pragma("unroll") for (int n = 0; n < 2; ++n) _Pragma("unroll") for (int k = 0; k < 2; ++k) dst[n][k] = *(const LAS bf16x8*)(lds + PG8_SB(b, h) + boff + n * 2048 + k * 1024); } while (0)
#define PG8_MMA(ai, bj, At, Bt) do { __builtin_amdgcn_s_setprio(1); _Pragma("unroll") for (int m = 0; m < 4; ++m) _Pragma("unroll") for (int n = 0; n < 2; ++n) _Pragma("unroll") for (int k = 0; k < 2; ++k) \
        acc[ai][bj][m][n] = __builtin_amdgcn_mfma_f32_16x16x32_bf16(Bt[n][k], At[m][k], acc[ai][bj][m][n], 0, 0, 0); __builtin_amdgcn_s_setprio(0); } while (0)
#define PG8_WAIT_V(n) asm volatile("s_waitcnt vmcnt(" #n ")" ::: "memory")
#define PG8_WAIT_L(n) asm volatile("s_waitcnt lgkmcnt(" #n ")" ::: "memory")
#define PG8_BAR __builtin_amdgcn_s_barrier()
#define PG8_SCHED __builtin_amdgcn_sched_barrier(0)
    Unit cur, nxt; int ui = 0;
    if (!S.next(0, cur)) return;
    f32x4 acc[2][2][4][2];
#pragma unroll
    for (int a = 0; a < 2; ++a)
#pragma unroll
        for (int b = 0; b < 2; ++b)
#pragma unroll
            for (int m = 0; m < 4; ++m)
#pragma unroll
                for (int n = 0; n < 2; ++n) acc[a][b][m][n] = (f32x4){0.f, 0.f, 0.f, 0.f};
    bf16x8 At[4][2], B0[2][2], B1[2][2];
    const char* cA = (const char*)g.A + S.aoff(cur); const char* cB = (const char*)g.Bt + S.boff(cur);
    if constexpr (SP2) {
        PG8_STAGE(PG8_SB(0, 0), cB, voffB); PG8_STAGE(PG8_SB(0, 1), cB + hstep, voffB); PG8_STAGE(PG8_SA(0, 0), cA, voffA); PG8_STAGE(PG8_SA(0, 1), cA + hstep, voffA);
        if (wr == 1) PG8_BAR;
        PG8_WAIT_V(2); PG8_BAR;
        PG8_STAGE(PG8_SB(1, 0), cB + kstep, voffB); PG8_STAGE(PG8_SA(1, 0), cA + kstep, voffA); PG8_STAGE(PG8_SB(1, 1), cB + hstep + kstep, voffB);
        PG8_WAIT_V(6); PG8_BAR;
    } else {
    PG8_STAGE(PG8_SB(0, 0), cB, voffB); PG8_STAGE(PG8_SA(0, 0), cA, voffA); PG8_STAGE(PG8_SB(0, 1), cB + hstep, voffB); PG8_STAGE(PG8_SA(0, 1), cA + hstep, voffA);
    if (wr == 1) PG8_BAR;
    PG8_WAIT_V(4); PG8_BAR;
    PG8_STAGE(PG8_SB(1, 0), cB + kstep, voffB); PG8_STAGE(PG8_SA(1, 0), cA + kstep, voffA); PG8_STAGE(PG8_SB(1, 1), cB + hstep + kstep, voffB);
    PG8_WAIT_V(6); PG8_BAR;
    }
    for (;;) {
        const bool has_next = S.next(ui + 1, nxt);
        const char* nA = has_next ? (const char*)g.A + S.aoff(nxt) : cA; const char* nB = has_next ? (const char*)g.Bt + S.boff(nxt) : cB;
        for (int t = 0; t < nt; t += 2) {
            const bool last = (t == nt - 2);
            const char* a1 = cA + (size_t)(t + 1) * kstep;
            const char* a2 = last ? nA : cA + (size_t)(t + 2) * kstep; const char* b2 = last ? nB : cB + (size_t)(t + 2) * kstep;
            const char* a3 = a2 + kstep; const char* b3 = b2 + kstep;
            if constexpr (SP2) {
            PG8_LDB(B0, 0, 0); PG8_LDB(B1, 0, 1); PG8_SCHED; PG8_LDA(At, 0, 0); PG8_STAGE(PG8_SA(1, 1), a1 + hstep, voffA);
            PG8_WAIT_V(8); PG8_WAIT_L(0); PG8_BAR; PG8_MMA(0, 0, At, B0); PG8_MMA(0, 1, At, B1); PG8_BAR; PG8_SCHED;
            PG8_LDA(At, 0, 1); PG8_STAGE(PG8_SB(0, 0), b2, voffB); PG8_STAGE(PG8_SB(0, 1), b2 + hstep, voffB); PG8_STAGE(PG8_SA(0, 0), a2, voffA);
            PG8_WAIT_V(8); PG8_WAIT_L(0); PG8_BAR; PG8_MMA(1, 0, At, B0); PG8_MMA(1, 1, At, B1); PG8_BAR; PG8_SCHED;
            PG8_LDB(B0, 1, 0); PG8_LDB(B1, 1, 1); PG8_SCHED; PG8_LDA(At, 1, 0); PG8_STAGE(PG8_SA(0, 1), a2 + hstep, voffA);
            PG8_WAIT_V(8); PG8_WAIT_L(0); PG8_BAR; PG8_MMA(0, 0, At, B0); PG8_MMA(0, 1, At, B1); PG8_BAR; PG8_SCHED;
            PG8_LDA(At, 1, 1); PG8_STAGE(PG8_SB(1, 0), b3, voffB); PG8_STAGE(PG8_SB(1, 1), b3 + hstep, voffB); PG8_STAGE(PG8_SA(1, 0), a3, voffA);
            PG8_WAIT_V(8); PG8_WAIT_L(0); PG8_BAR; PG8_MMA(1, 0, At, B0); PG8_MMA(1, 1, At, B1); PG8_BAR; PG8_SCHED;
            } else {
            PG8_LDB(B0, 0, 0); PG8_SCHED; PG8_LDA(At, 0, 0); PG8_STAGE(PG8_SA(1, 1), a1 + hstep, voffA);
            PG8_WAIT_L(8); PG8_BAR; PG8_WAIT_L(0); PG8_MMA(0, 0, At, B0); PG8_BAR; PG8_SCHED;
            PG8_LDB(B1, 0, 1); PG8_STAGE(PG8_SB(0, 0), b2, voffB);
            PG8_BAR; PG8_WAIT_L(0); PG8_MMA(0, 1, At, B1); PG8_BAR;
            PG8_LDA(At, 0, 1); PG8_STAGE(PG8_SA(0, 0), a2, voffA);
            PG8_BAR; PG8_WAIT_L(0); PG8_MMA(1, 0, At, B0); PG8_BAR; PG8_SCHED;
            PG8_STAGE(PG8_SB(0, 1), b2 + hstep, voffB);
            PG8_WAIT_V(6); PG8_BAR; PG8_MMA(1, 1, At, B1); PG8_BAR;
            PG8_LDB(B0, 1, 0); PG8_SCHED; PG8_LDA(At, 1, 0); PG8_STAGE(PG8_SA(0, 1), a2 + hstep, voffA);
            PG8_WAIT_L(8); PG8_BAR; PG8_WAIT_L(0); PG8_MMA(0, 0, At, B0); PG8_BAR; PG8_SCHED;
            PG8_LDB(B1, 1, 1); PG8_STAGE(PG8_SB(1, 0), b3, voffB);
            PG8_BAR; PG8_WAIT_L(0); PG8_MMA(0, 1, At, B1); PG8_BAR;
            PG8_LDA(At, 1, 1); PG8_STAGE(PG8_SA(1, 0), a3, voffA);
            PG8_BAR; PG8_WAIT_L(0); PG8_MMA(1, 0, At, B0); PG8_BAR; PG8_SCHED;
            PG8_STAGE(PG8_SB(1, 1), b3 + hstep, voffB);
            PG8_WAIT_V(6); PG8_BAR; PG8_MMA(1, 1, At, B1); PG8_BAR;
            }
        }
        if constexpr (ALIGN_EPI) { if (wr == 0) PG8_BAR; }
        E(acc, cur, wr, wc, fr, fq);
        if (!has_next) break;
#pragma unroll
        for (int a = 0; a < 2; ++a)
#pragma unroll
            for (int b = 0; b < 2; ++b)
#pragma unroll
                for (int m = 0; m < 4; ++m)
#pragma unroll
                    for (int n = 0; n < 2; ++n) acc[a][b][m][n] = (f32x4){0.f, 0.f, 0.f, 0.f};
        cur = nxt; cA = nA; cB = nB; ++ui;
        if constexpr (ALIGN_EPI) { if (wr == 1) PG8_BAR; }
    }
    PG8_WAIT_V(0);
    if constexpr (!ALIGN_EPI) { if (wr == 0) PG8_BAR; }
    PG8_BAR;
#undef PG8_SA
#undef PG8_SB
#undef PG8_STAGE
#undef PG8_LDA
#undef PG8_LDB
#undef PG8_MMA
#undef PG8_WAIT_V
#undef PG8_WAIT_L
#undef PG8_BAR
#undef PG8_SCHED
}
}

struct Epi1 {
    static constexpr bool PERM = true;
    unsigned char* ws; const float* dt_bias;
    FI void operator()(const f32x4 (&acc)[2][2][4][2], const pg8::Unit& u, int wr, int wc, int fr, int fq) const {
        unsigned char* ws = this->ws; asm volatile("" : "+s"(ws));
        const float* dt_bias = this->dt_bias; asm volatile("" : "+s"(dt_bias));
        const int pn = u.pn;
        int mode, ld, cb; size_t off;
        if (pn < 4) { mode = 0; off = OFF_PV; ld = 1024; cb = pn * 256; }
        else if (pn < 8) { mode = 1; off = OFF_PG; ld = 1024; cb = (pn - 4) * 256; }
        else if (pn < 16) { mode = 1; off = OFF_ZS; ld = 2048; cb = (pn - 8) * 256; }
        else if (pn < 28) { mode = 0; off = OFF_XBC; ld = 3072; cb = (pn - 16) * 256; }
        else if (pn < 32) { mode = 2; off = OFF_Q; ld = 1024; cb = (pn - 28) * 256; }
        else if (pn == 32) { mode = 2; off = OFF_K; ld = 256; cb = 0; }
        else if (pn == 33) { mode = 0; off = OFF_V; ld = 256; cb = 0; }
        else if (pn < 38) { mode = 1; off = OFF_AG; ld = 1024; cb = (pn - 34) * 256; }
        else if (pn < 42) { mode = 3; off = OFF_IQ; ld = 1024; cb = (pn - 38) * 256; }
        else { mode = 4; off = OFF_IK; ld = 64; cb = 0; }
        bf16_t* dst = (bf16_t*)(ws + off);
        const float* cosA = (const float*)(ws + OFF_ROPEA); const float* sinA = cosA + MR * 16;
        const float* cosI = (const float*)(ws + OFF_ROPEI); const float* sinI = cosI + MR * 8;
        float* DT = (float*)(ws + OFF_DT); float* IW = (float*)(ws + OFF_IW);
        const int row0 = u.pm * 256 + wr * 64 + fr;
#pragma unroll
        for (int ai = 0; ai < 2; ++ai)
#pragma unroll
            for (int m = 0; m < 4; ++m) {
                const int row = row0 + ai * 128 + m * 16;
#pragma unroll
                for (int bj = 0; bj < 2; ++bj) {
                    const int cl = bj * 128 + wc * 32 + 8 * fq;
                    float v[8];
#pragma unroll
                    for (int e = 0; e < 4; ++e) { v[e] = acc[ai][bj][m][0][e]; v[4 + e] = acc[ai][bj][m][1][e]; }
                    if (mode == 1) {
#pragma unroll
                        for (int e = 0; e < 8; ++e) v[e] = silu_f(v[e]);
                    } else if (mode == 2) {
                        if (wc == 0) {
                            const f32x4 c0 = *(const f32x4*)(cosA + row * 16 + 8 * (fq & 1)), c1 = *(const f32x4*)(cosA + row * 16 + 8 * (fq & 1) + 4);
                            const f32x4 s0 = *(const f32x4*)(sinA + row * 16 + 8 * (fq & 1)), s1 = *(const f32x4*)(sinA + row * 16 + 8 * (fq & 1) + 4);
#pragma unroll
                            for (int e = 0; e < 8; ++e) { const float o = __shfl_xor(v[e], 32); const float c = e < 4 ? c0[e & 3] : c1[e & 3], s = e < 4 ? s0[e & 3] : s1[e & 3];
                                v[e] = (fq < 2) ? v[e] * c - o * s : v[e] * c + o * s; }
                        }
                    } else if (mode == 3) {
                        if ((wc & 1) == 0) {
                            const f32x4 c0 = *(const f32x4*)(cosI + row * 8), c1 = *(const f32x4*)(cosI + row * 8 + 4);
                            const f32x4 s0 = *(const f32x4*)(sinI + row * 8), s1 = *(const f32x4*)(sinI + row * 8 + 4);
#pragma unroll
                            for (int e = 0; e < 8; ++e) { const float o = __shfl_xor(v[e], 16); const float c = e < 4 ? c0[e & 3] : c1[e & 3], s = e < 4 ? s0[e & 3] : s1[e & 3];
                                const float r = (fq == 0) ? v[e] * c - o * s : v[e] * c + o * s; v[e] = (fq < 2) ? r : v[e]; }
                        }
                    }
                    if (mode != 4) { *(u32x4*)(dst + (size_t)row * ld + cb + cl) = pack8(v); }
                    else if (bj == 0) {
                        if (wc == 0) {
#pragma unroll
                            for (int e = 0; e < 8; ++e) { const float x = v[e] + dt_bias[8 * fq + e]; float ln2c = 0.69314718f; asm volatile("" : "+v"(ln2c));
                                const float sp = x > 20.f ? x : __log2f(1.f + __expf(x)) * ln2c; v[e] = row >= ROW0 ? sp : 0.f; }
                            *(f32x4*)(DT + row * 32 + 8 * fq) = (f32x4){v[0], v[1], v[2], v[3]}; *(f32x4*)(DT + row * 32 + 8 * fq + 4) = (f32x4){v[4], v[5], v[6], v[7]};
                        } else if (wc == 1) {
                            const f32x4 c0 = *(const f32x4*)(cosI + row * 8), c1 = *(const f32x4*)(cosI + row * 8 + 4);
                            const f32x4 s0 = *(const f32x4*)(sinI + row * 8), s1 = *(const f32x4*)(sinI + row * 8 + 4);
#pragma unroll
                            for (int e = 0; e < 8; ++e) { const float o = __shfl_xor(v[e], 16); const float c = e < 4 ? c0[e & 3] : c1[e & 3], s = e < 4 ? s0[e & 3] : s1[e & 3];
                                const float r = (fq == 0) ? v[e] * c - o * s : v[e] * c + o * s; v[e] = (fq < 2) ? r : v[e]; }
                            *(u32x4*)(dst + (size_t)row * 64 + 8 * fq) = pack8(v);
                        } else if (wc == 2) {
                            *(u32x4*)(dst + (size_t)row * 64 + 32 + 8 * fq) = pack8(v);
                        } else if (fq < 2) {
                            const float sc = 0.125f * 0.25f;
                            *(f32x4*)(IW + row * 16 + 8 * fq) = (f32x4){v[0] * sc, v[1] * sc, v[2] * sc, v[3] * sc}; *(f32x4*)(IW + row * 16 + 8 * fq + 4) = (f32x4){v[4] * sc, v[5] * sc, v[6] * sc, v[7] * sc};
                        }
                    }
                }
            }
    }
};
struct EpiOut {
    static constexpr bool PERM = true;
    float* O; int rowoff;
    FI void operator()(const f32x4 (&acc)[2][2][4][2], const pg8::Unit& u, int wr, int wc, int fr, int fq) const {
        float* O = this->O; asm volatile("" : "+s"(O));
        const int row0 = u.pm * 256 + wr * 64 + fr + rowoff;
#pragma unroll
        for (int ai = 0; ai < 2; ++ai)
#pragma unroll
            for (int m = 0; m < 4; ++m)
#pragma unroll
                for (int bj = 0; bj < 2; ++bj) {
                    float* p = O + (size_t)(row0 + ai * 128 + m * 16) * DM + u.pn * 256 + bj * 128 + wc * 32 + 8 * fq;
                    *(f32x4*)p = acc[ai][bj][m][0]; *(f32x4*)(p + 4) = acc[ai][bj][m][1];
                    __builtin_amdgcn_sched_barrier(0);
                }
    }
};
struct EpiPool {
    static constexpr bool PERM = true;
    bf16_t* MIX; const bf16_t* PG; const float* pscale;
    FI void operator()(const f32x4 (&acc)[2][2][4][2], const pg8::Unit& u, int wr, int wc, int fr, int fq) const {
        bf16_t* MIX = this->MIX; asm volatile("" : "+s"(MIX));
        const bf16_t* PG = this->PG; asm volatile("" : "+s"(PG));
        const float* pscale = this->pscale; asm volatile("" : "+s"(pscale));
        const int grp = u.pm / 33, row0 = (u.pm % 33) * 256 + wr * 64 + fr;
#pragma unroll
        for (int ai = 0; ai < 2; ++ai)
#pragma unroll
            for (int m = 0; m < 4; ++m)
#pragma unroll
                for (int bj = 0; bj < 2; ++bj) {
                    const int row = row0 + ai * 128 + m * 16, col = grp * 256 + bj * 128 + wc * 32 + 8 * fq;
                    float g[8]; unpack8(*(const u32x4*)(PG + (size_t)row * 1024 + col), g);
                    const f32x4 p0 = *(const f32x4*)(pscale + col), p1 = *(const f32x4*)(pscale + col + 4);
                    float v[8];
#pragma unroll
                    for (int e = 0; e < 4; ++e) { v[e] = acc[ai][bj][m][0][e] * p0[e] * g[e]; v[4 + e] = acc[ai][bj][m][1][e] * p1[e] * g[4 + e]; }
                    *(u32x4*)(MIX + (size_t)row * DMIX + col) = pack8(v);
                    __builtin_amdgcn_sched_barrier(0);
                }
    }
};

FI int src_col_win(int np) {
    if (np < 7168) return np;
    if (np < 10752) return np + 32;
    if (np < 10784) return 7168 + (np - 10752);
    if (np < 10864) return np;
    return -1;
}
template <bool MAP>
FI void transpose_item(const float* W, int K, int N, bf16_t* WT, float* scr, int item, int nblk, int lane) {
    const int kb = item / nblk, nb = item % nblk, k0 = 64 * kb, n0 = 32 * nb;
    int sc = n0 + (lane & 31); if (MAP) sc = src_col_win(sc);
    float tv[32];
#pragma unroll
    for (int i = 0; i < 32; ++i) { const int kk = 2 * i + (lane >> 5); tv[i] = sc >= 0 ? W[(size_t)(k0 + kk) * N + sc] : 0.f; }
#pragma unroll
    for (int i = 0; i < 32; ++i) { const int kk = 2 * i + (lane >> 5); scr[kk * 33 + (lane & 31)] = tv[i]; }
    asm volatile("s_waitcnt lgkmcnt(0)" ::: "memory");
    const int c = lane & 7;
#pragma unroll
    for (int j = 0; j < 4; ++j) { const int n = (lane >> 3) + 8 * j; const float* s = scr + (8 * c) * 33 + n;
        u32x4 o; o.x = cvt_pk_bf16(s[0 * 33], s[1 * 33]); o.y = cvt_pk_bf16(s[2 * 33], s[3 * 33]); o.z = cvt_pk_bf16(s[4 * 33], s[5 * 33]); o.w = cvt_pk_bf16(s[6 * 33], s[7 * 33]);
        *(u32x4*)(WT + (size_t)(n0 + n) * K + k0 + 8 * c) = o; }
    asm volatile("s_waitcnt lgkmcnt(0)" ::: "memory");
}
FI void convert_weights(const Args& a, int layer, unsigned char* lds) {
    const int tid = tid_l(), lane = tid & 63, w = tid >> 6;
    float* scr = (float*)(lds + w * 16384);
    const int gw = blockIdx.x * 8 + w, NGW = gridDim.x * 8;
    constexpr int I_IN = (DM / 64) * (NP / 32), I_OUT = (DMIX / 64) * (DM / 32);
    const float* win = a.in[4] + (size_t)layer * DM * 10864; const float* wout = a.in[13] + (size_t)layer * DMIX * DM;
    bf16_t* WIN = (bf16_t*)(a.ws + OFF_WIN); bf16_t* WOUT = (bf16_t*)(a.ws + OFF_WOUT);
#pragma unroll 1
    for (int it = gw; it < I_IN + I_OUT; it += NGW) {
        if (it < I_IN) transpose_item<true>(win, DM, 10864, WIN, scr, it, NP / 32, lane);
        else transpose_item<false>(wout, DMIX, DM, WOUT, scr, it - I_IN, DM / 32, lane);
    }
}
FI void convert_pool_w(const Args& a, unsigned char* lds) {
    const int tid = tid_l(), lane = tid & 63, w = tid >> 6;
    float* scr = (float*)(lds + w * 16384);
    const int gw = blockIdx.x * 8 + w, NGW = gridDim.x * 8;
    bf16_t* PWT = (bf16_t*)(a.ws + OFF_PWT);
#pragma unroll 1
    for (int it = gw; it < 8 * 32; it += NGW) { const int mat = it >> 5;
        transpose_item<false>(a.in[5] + (size_t)mat * 65536, 256, 256, PWT + (size_t)mat * 65536, scr, it & 31, 8, lane); }
}
FI void rope_tables(const Args& a) {
    float* cosA = (float*)(a.ws + OFF_ROPEA); float* sinA = cosA + MR * 16;
    float* cosI = (float*)(a.ws + OFF_ROPEI); float* sinI = cosI + MR * 8;
    const int gt = blockIdx.x * 512 + tid_l(), NT = gridDim.x * 512;
#pragma unroll 1
    for (int i = gt; i < MR * 24; i += NT) {
        const int row = i / 24, j = i % 24; const int pos = row >= ROW0 ? row - ROW0 : 0;
        const float ex = j < 16 ? -(float)j * (2.0f / 32.0f) : -(float)(j - 16) * (2.0f / 16.0f);
        const float inv = exp2f(ex * 18.931568569324174f);
        const float ang = (float)pos * inv;
        double rev = (double)ang * 0.15915494309189535; rev -= rint(rev);
        const float rf = (float)rev;
        const float cs = __builtin_amdgcn_cosf(rf), sn = __builtin_amdgcn_sinf(rf);
        if (j < 16) { cosA[row * 16 + j] = cs; sinA[row * 16 + j] = sn; } else { cosI[row * 8 + j - 16] = cs; sinI[row * 8 + j - 16] = sn; }
    }
}
FI void row_pass(const Args& a, int mode, int layer) {
    const int tid = tid_l(), lane = tid & 63, w = tid >> 6;
    const int gw = blockIdx.x * 8 + w, NGW = gridDim.x * 8;
    float* H = (float*)(a.ws + OFF_H); bf16_t* U = (bf16_t*)(a.ws + OFF_U); const float* OUT = (const float*)(a.ws + OFF_OUT);
    const float* postw = a.in[3] + (size_t)layer * DM;
    const float* prew = a.in[2] + (size_t)(mode == 0 ? 0 : layer + 1) * DM;
#pragma unroll 1
    for (int row = gw; row < MR; row += NGW) {
        if (row < ROW0) {
            if (mode != 2) {
#pragma unroll
                for (int j = 0; j < 8; ++j) { if (mode == 0) *(f32x4*)(H + (size_t)row * DM + 4 * lane + 256 * j) = (f32x4){0.f, 0.f, 0.f, 0.f};
                    *(u32x2*)(U + (size_t)row * DM + 4 * lane + 256 * j) = (u32x2){0u, 0u}; }
            }
            continue;
        }
        if (mode == 2 && row < 256) continue;
        f32x4 h[8];
        if (mode == 0) {
            const float* src = row < 256 ? a.in[1] + (size_t)(row - ROW0) * DM : a.in[0] + (size_t)(row - 256) * DM;
#pragma unroll
            for (int j = 0; j < 8; ++j) h[j] = *(const f32x4*)(src + 4 * lane + 256 * j);
        } else {
            f32x4 o[8]; float ss = 0.f;
#pragma unroll
            for (int j = 0; j < 8; ++j) { o[j] = *(const f32x4*)(OUT + (size_t)row * DM + 4 * lane + 256 * j); ss += o[j].x * o[j].x + o[j].y * o[j].y + o[j].z * o[j].z + o[j].w * o[j].w; }
            const float rstd = rsqrtf(wave_sum(ss) * (1.f / DM) + EPS);
#pragma unroll
            for (int j = 0; j < 8; ++j) { const f32x4 pw = *(const f32x4*)(postw + 4 * lane + 256 * j); h[j] = *(const f32x4*)(H + (size_t)row * DM + 4 * lane + 256 * j) + o[j] * rstd * pw; }
        }
        if (mode == 2) {
#pragma unroll
            for (int j = 0; j < 8; ++j) *(f32x4*)(a.out + (size_t)(row - 256) * DM + 4 * lane + 256 * j) = h[j];
            continue;
        }
        float ss = 0.f;
#pragma unroll
        for (int j = 0; j < 8; ++j) { *(f32x4*)(H + (size_t)row * DM + 4 * lane + 256 * j) = h[j]; ss += h[j].x * h[j].x + h[j].y * h[j].y + h[j].z * h[j].z + h[j].w * h[j].w; }
        const float rstd = rsqrtf(wave_sum(ss) * (1.f / DM) + EPS);
#pragma unroll
        for (int j = 0; j < 8; ++j) { const f32x4 pw = *(const f32x4*)(prew + 4 * lane + 256 * j); const f32x4 u = h[j] * rstd * pw;
            *(u32x2*)(U + (size_t)row * DM + 4 * lane + 256 * j) = (u32x2){cvt_pk_bf16(u.x, u.y), cvt_pk_bf16(u.z, u.w)}; }
    }
}

FI void conv8(const bf16_t* XBC, const float* cw, const float* cbias, int R, int col, float* o) {
    if (R < ROW0) {
#pragma unroll
        for (int e = 0; e < 8; ++e) o[e] = 0.f;
        return;
    }
    const f32x4 b0 = *(const f32x4*)(cbias + col), b1 = *(const f32x4*)(cbias + col + 4);
#pragma unroll
    for (int e = 0; e < 4; ++e) { o[e] = b0[e]; o[4 + e] = b1[e]; }
#pragma unroll
    for (int i = 0; i < 4; ++i) {
        float x[8]; unpack8(*(const u32x4*)(XBC + (size_t)(R - 3 + i) * 3072 + col), x);
        const f32x4 w0 = *(const f32x4*)(cw + i * 3072 + col), w1 = *(const f32x4*)(cw + i * 3072 + col + 4);
#pragma unroll
        for (int e = 0; e < 4; ++e) { o[e] += x[e] * w0[e]; o[4 + e] += x[4 + e] * w1[e]; }
    }
#pragma unroll
    for (int e = 0; e < 8; ++e) o[e] = silu_f(o[e]);
}
constexpr int LDP = 136;
FI bf16x8 ldsfrag(const bf16_t* base, int row0, int kk, int lane) { return *(const bf16x8*)(base + (row0 + (lane & 31)) * LDP + kk * 16 + 8 * (lane >> 5)); }

FI void ssd_s1(const Args& a, int layer, int c, int g, unsigned char* lds) {
    const int tid = tid_l(), lane = tid & 63, w = tid >> 6;
    const int r0 = 128 + 128 * c;
    bf16_t* cmS = (bf16_t*)lds; bf16_t* bmS = cmS + 128 * LDP; bf16_t* bmT = bmS + 128 * LDP;
    bf16_t* G = cmS; bf16_t* xdtT = bmS; bf16_t* xdtdT = bmS + 64 * LDP;
    float* csS = (float*)(lds + 104448); float* dtS = csS + 1024;
    const bf16_t* XBC = (const bf16_t*)(a.ws + OFF_XBC);
    const float* cw = a.in[7] + (size_t)layer * 4 * 3072; const float* cbias = a.in[8] + (size_t)layer * 3072;
    const float* DT = (const float*)(a.ws + OFF_DT);
    bf16_t* CM = (bf16_t*)(a.ws + OFF_CM); bf16_t* XS = (bf16_t*)(a.ws + OFF_XS);
    float* CSB = (float*)(a.ws + OFF_CSB); bf16_t* YD = (bf16_t*)(a.ws + OFF_YD); float* ST = (float*)(a.ws + OFF_ST); float* CD = (float*)(a.ws + OFF_CD);
#pragma unroll 4
    for (int it = tid; it < 4096; it += 512) {
        const int mat = it >> 11, row = (it >> 4) & 127, cg8 = it & 15;
        const int col = 2048 + mat * 512 + g * 128 + cg8 * 8, R = r0 + row;
        float o[8]; conv8(XBC, cw, cbias, R, col, o);
        const u32x4 pk = pack8(o);
        if (mat == 0) {
            *(u32x4*)(bmS + row * LDP + cg8 * 8) = pk;
#pragma unroll
            for (int e = 0; e < 8; ++e) bmT[(cg8 * 8 + e) * LDP + row] = f2bf(o[e]);
        } else {
            *(u32x4*)(cmS + row * LDP + cg8 * 8) = pk;
            *(u32x4*)(CM + (size_t)R * 512 + g * 128 + cg8 * 8) = pk;
        }
    }
    __syncthreads();
    f32x16 cb[2];
#pragma unroll
    for (int i = 0; i < 16; ++i) { cb[0][i] = 0.f; cb[1][i] = 0.f; }
    const int m0 = 32 * (w >> 1);
    {
        const int n0 = 64 * (w & 1);
#pragma unroll
        for (int kk = 0; kk < 8; ++kk) { const bf16x8 av = ldsfrag(cmS, m0, kk, lane);
            cb[0] = mfma32(av, ldsfrag(bmS, n0, kk, lane), cb[0]); cb[1] = mfma32(av, ldsfrag(bmS, n0 + 32, kk, lane), cb[1]); }
    }
    {
        const int h = 8 * g + w; const float ah = -__expf(a.in[10][layer * 32 + h]);
        const float d0 = DT[(r0 + 2 * lane) * 32 + h], d1 = DT[(r0 + 2 * lane + 1) * 32 + h];
        const float a0 = d0 * ah, a1 = d1 * ah; float s = a0 + a1;
#pragma unroll
        for (int o = 1; o < 64; o <<= 1) { const float t = __shfl_up(s, o); if (lane >= o) s += t; }
        csS[w * 128 + 2 * lane] = s - a1; csS[w * 128 + 2 * lane + 1] = s; dtS[w * 128 + 2 * lane] = d0; dtS[w * 128 + 2 * lane + 1] = d1;
        CSB[(r0 + 2 * lane) * 32 + h] = s - a1; CSB[(r0 + 2 * lane + 1) * 32 + h] = s;
        if (lane == 63) CD[c * 32 + h] = __expf(s);
    }
    __syncthreads();
#pragma unroll 1
    for (int r = 0; r < 8; ++r) {
        const int h = 8 * g + r;
        {
            int ln = lane; asm volatile("" : "+v"(ln));
            const int n0 = 64 * (w & 1);
#pragma unroll
            for (int t = 0; t < 2; ++t)
#pragma unroll
                for (int i = 0; i < 16; ++i) { const int l = m0 + (i & 3) + 8 * (i >> 2) + 4 * (ln >> 5), s = n0 + 32 * t + (ln & 31);
                    const int msk = (s - l - 1) >> 31;
                    const float v = __uint_as_float(__float_as_uint(cb[t][i] * __expf(fminf(csS[r * 128 + l] - csS[r * 128 + s], 0.f))) & (unsigned)msk);
                    G[l * LDP + s] = f2bf(v); if ((i & 3) == 3) __builtin_amdgcn_sched_barrier(0); }
        }
#pragma unroll 2
        for (int it = tid; it < 1024; it += 512) {
            const int row = it >> 3, pg = it & 7, R = r0 + row, col = h * 64 + pg * 8;
            float o[8]; conv8(XBC, cw, cbias, R, col, o);
            __builtin_nontemporal_store(pack8(o), (u32x4*)(XS + (size_t)R * 2048 + col));
            const float dtv = dtS[r * 128 + row], dec = __expf(csS[r * 128 + 127] - csS[r * 128 + row]);
#pragma unroll
            for (int e = 0; e < 8; ++e) { const float xd = o[e] * dtv; xdtT[(pg * 8 + e) * LDP + row] = f2bf(xd); xdtdT[(pg * 8 + e) * LDP + row] = f2bf(xd * dec); }
        }
        __syncthreads();
        {
            const int n0 = 32 * (w & 1); f32x16 acc;
#pragma unroll
            for (int i = 0; i < 16; ++i) acc[i] = 0.f;
#pragma unroll
            for (int kk = 0; kk < 8; ++kk) acc = mfma32(ldsfrag(G, m0, kk, lane), ldsfrag(xdtT, n0, kk, lane), acc);
#pragma unroll
            for (int i = 0; i < 16; ++i) { const int l = m0 + (i & 3) + 8 * (i >> 2) + 4 * (lane >> 5); __builtin_nontemporal_store(f2bf(acc[i]), &YD[(size_t)(r0 + l) * 2048 + h * 64 + n0 + (lane & 31)]); }
        }
        {
            const int p0 = 32 * (w >> 2), n0 = 32 * (w & 3); f32x16 acc;
#pragma unroll
            for (int i = 0; i < 16; ++i) acc[i] = 0.f;
#pragma unroll
            for (int kk = 0; kk < 8; ++kk) acc = mfma32(ldsfrag(xdtdT, p0, kk, lane), ldsfrag(bmT, n0, kk, lane), acc);
#pragma unroll
            for (int i = 0; i < 16; ++i) { const int pp = p0 + (i & 3) + 8 * (i >> 2) + 4 * (lane >> 5); __builtin_nontemporal_store(acc[i], &ST[((size_t)(c * 32 + h) * 64 + pp) * 128 + n0 + (lane & 31)]); }
        }
        __syncthreads();
    }
}

FI void ssd_scan_item(const Args& a, int item) {
    const int q = item * 512 + tid_l();
    const int h = q >> 11;
    const f32x4* base = (const f32x4*)(a.ws + OFF_ST) + q; const float* CD = (const float*)(a.ws + OFF_CD);
    u32x2* hs = (u32x2*)(a.ws + OFF_HS) + q;
    f32x4 state = (f32x4){0.f, 0.f, 0.f, 0.f};
#pragma unroll 1
    for (int c0 = 0; c0 < NCH; c0 += 13) {
        f32x4 v[13]; float cd[13];
#pragma unroll
        for (int j = 0; j < 13; ++j) { v[j] = __builtin_nontemporal_load(&base[(size_t)(c0 + j) * 65536]); cd[j] = CD[(c0 + j) * 32 + h]; }
#pragma unroll
        for (int j = 0; j < 13; ++j) { hs[(size_t)(c0 + j) * 65536] = (u32x2){cvt_pk_bf16(state.x, state.y), cvt_pk_bf16(state.z, state.w)}; state = state * cd[j] + v[j]; }
    }
}

FI void ssd_s3(const Args& a, int layer, int c, int g, unsigned char* lds) {
    const int tid = tid_l(), lane = tid & 63, w = tid >> 6;
    const int r0 = 128 + 128 * c;
    bf16_t* cmS = (bf16_t*)lds; bf16_t* Hs = cmS + 128 * LDP; float* rowss = (float*)(lds + 53248);
    const bf16_t* CM = (const bf16_t*)(a.ws + OFF_CM); const bf16_t* XS = (const bf16_t*)(a.ws + OFF_XS); const bf16_t* ZS = (const bf16_t*)(a.ws + OFF_ZS);
    const float* CSB = (const float*)(a.ws + OFF_CSB); const bf16_t* YD = (const bf16_t*)(a.ws + OFF_YD); const float* ST = (const float*)(a.ws + OFF_ST);
    bf16_t* MIX = (bf16_t*)(a.ws + OFF_MIX);
    const float* dskip = a.in[11] + layer * 32; const float* normw = a.in[12] + (size_t)layer * 2048;
    {
        u32x4 t[4];
#pragma unroll
        for (int j = 0; j < 4; ++j) { const int it = tid + 512 * j, row = it >> 4, cg8 = it & 15; t[j] = *(const u32x4*)(CM + (size_t)(r0 + row) * 512 + g * 128 + cg8 * 8); }
#pragma unroll
        for (int j = 0; j < 4; ++j) { const int it = tid + 512 * j, row = it >> 4, cg8 = it & 15; *(u32x4*)(cmS + row * LDP + cg8 * 8) = t[j]; }
    }
    if (tid < 128) rowss[tid] = 0.f;
    const int pt = w & 1, lt = w >> 1;
    const int l = lt * 32 + (lane & 31), R = r0 + l;
    const bf16_t* HSB = (const bf16_t*)(a.ws + OFF_HS);
    u32x4 hreg[2];
    {
        const bf16_t* src = HSB + ((size_t)(c * 32 + 8 * g) * 64) * 128;
#pragma unroll
        for (int j = 0; j < 2; ++j) { const int it = tid + 512 * j; hreg[j] = __builtin_nontemporal_load((const u32x4*)(src + (size_t)(it >> 4) * 128 + (it & 15) * 8)); }
    }
    float ss = 0.f;
#pragma unroll 1
    for (int r = 0; r < 8; ++r) {
        const int h = 8 * g + r;
        __syncthreads();
#pragma unroll
        for (int j = 0; j < 2; ++j) { const int it = tid + 512 * j; *(u32x4*)(Hs + (it >> 4) * LDP + (it & 15) * 8) = hreg[j]; }
        __syncthreads();
        if (r < 7) {
            const bf16_t* src = HSB + ((size_t)(c * 32 + h + 1) * 64) * 128;
#pragma unroll
            for (int j = 0; j < 2; ++j) { const int it = tid + 512 * j; hreg[j] = __builtin_nontemporal_load((const u32x4*)(src + (size_t)(it >> 4) * 128 + (it & 15) * 8)); }
        }
        const int colb = h * 64 + pt * 32 + 4 * (lane >> 5);
        f32x4 yd[4]; u32x2 xs[4], zs[4];
#pragma unroll
        for (int q = 0; q < 4; ++q) { const size_t o = (size_t)R * 2048 + colb + 8 * q; { const u32x2 yr = __builtin_nontemporal_load((const u32x2*)(YD + o)); yd[q] = (f32x4){bflo(yr.x), bfhi(yr.x), bflo(yr.y), bfhi(yr.y)}; } xs[q] = __builtin_nontemporal_load((const u32x2*)(XS + o)); zs[q] = __builtin_nontemporal_load((const u32x2*)(ZS + o)); }
        const float ecs = __expf(CSB[R * 32 + h]), dsk = dskip[h];
        f32x16 acc;
#pragma unroll
        for (int i = 0; i < 16; ++i) acc[i] = 0.f;
#pragma unroll
        for (int kk = 0; kk < 8; ++kk) acc = mfma32(ldsfrag(Hs, pt * 32, kk, lane), ldsfrag(cmS, lt * 32, kk, lane), acc);
#pragma unroll
        for (int q = 0; q < 4; ++q) {
            const float y0 = (yd[q].x + acc[4 * q] * ecs + dsk * bflo(xs[q].x)) * bflo(zs[q].x);
            const float y1 = (yd[q].y + acc[4 * q + 1] * ecs + dsk * bfhi(xs[q].x)) * bfhi(zs[q].x);
            const float y2 = (yd[q].z + acc[4 * q + 2] * ecs + dsk * bflo(xs[q].y)) * bflo(zs[q].y);
            const float y3 = (yd[q].w + acc[4 * q + 3] * ecs + dsk * bfhi(xs[q].y)) * bfhi(zs[q].y);
            const unsigned w0 = cvt_pk_bf16(y0, y1), w1 = cvt_pk_bf16(y2, y3);
            const float b0 = bflo(w0), b1 = bfhi(w0), b2 = bflo(w1), b3 = bfhi(w1);
            ss += b0 * b0 + b1 * b1 + b2 * b2 + b3 * b3;
            *(u32x2*)(MIX + (size_t)R * DMIX + 1024 + colb + 8 * q) = (u32x2){w0, w1};
        }
    }
    ss += __shfl_xor(ss, 32);
    if (lane < 32) atomicAdd(&rowss[l], ss);
    __threadfence();
    __syncthreads();
#pragma unroll 1
    for (int l2 = w * 16; l2 < w * 16 + 16; l2 += 4) {
        u32x4 t[4];
#pragma unroll
        for (int j = 0; j < 4; ++j) t[j] = *(const u32x4*)(MIX + (size_t)(r0 + l2 + j) * DMIX + 1024 + g * 512 + lane * 8);
        const f32x4 n0v = *(const f32x4*)(normw + g * 512 + lane * 8), n1v = *(const f32x4*)(normw + g * 512 + lane * 8 + 4);
#pragma unroll
        for (int j = 0; j < 4; ++j) {
            float v[8]; unpack8(t[j], v);
            const float rstd = rsqrtf(rowss[l2 + j] * (1.f / 512.f) + EPS);
#pragma unroll
            for (int e = 0; e < 4; ++e) { v[e] *= rstd * n0v[e]; v[4 + e] *= rstd * n1v[e]; }
            *(u32x4*)(MIX + (size_t)(r0 + l2 + j) * DMIX + 1024 + g * 512 + lane * 8) = pack8(v);
        }
    }
}

FI void pool_pre_item(const Args& a, int item) {
    const bf16_t* PV = (const bf16_t*)(a.ws + OFF_PV); bf16_t* PA = (bf16_t*)(a.ws + OFF_U);
    const int q = tid_l();
    const int col = (q & 127) * 8, grp = col >> 8, r0 = item * 32 + (q >> 7) * 8, wdw = 2 << grp;
    u32x4 raw[23];
#pragma unroll
    for (int j = 0; j < 23; ++j) { const int rr = r0 - 15 + j; raw[j] = *(const u32x4*)(PV + (size_t)(rr < 0 ? 0 : rr) * 1024 + col); }
#pragma unroll
    for (int i = 0; i < 8; ++i) {
        const int row = r0 + i, t = row - ROW0;
        float y[8];
#pragma unroll
        for (int e = 0; e < 8; ++e) y[e] = 0.f;
        if (t >= 0) {
            float v0[8]; unpack8(raw[15 + i], v0);
            float sacc[8];
#pragma unroll
            for (int e = 0; e < 8; ++e) sacc[e] = v0[e];
#pragma unroll
            for (int j = 1; j < 16; ++j) { float x[8]; unpack8(raw[15 + i - j], x); const float m = j < wdw ? 1.f : 0.f;
#pragma unroll
                for (int e = 0; e < 8; ++e) sacc[e] += m * x[e]; }
            const float ic = 1.f / (float)min(wdw, t + 1);
#pragma unroll
            for (int e = 0; e < 8; ++e) y[e] = sacc[e] * ic - v0[e];
        }
        *(u32x4*)(PA + ((size_t)grp * MR + row) * 256 + (col & 255)) = pack8(y);
    }
}

constexpr int IDX_BLOCK_TASKS = 1188;
template <int MODE>
FI void indexer_block_task(const Args& a, int id, unsigned char* lds) {
    const int tid = tid_l(), lane = tid & 63, w = tid >> 6;
    int m = 65, rem = id;
    for (;;) { const int c = 4 * ((m + 7) >> 3); if (rem < c) break; rem -= c; --m; }
    const int per = (m + 7) >> 3, r = rem / per, j = rem - r * per;
    const int qg = 4 * m + r, qrow0 = 32 * qg, qb = qrow0 >> 8;
    const bf16_t* IQ = (const bf16_t*)(a.ws + OFF_IQ); const bf16_t* IK = (const bf16_t*)(a.ws + OFF_IK); const float* IW = (const float*)(a.ws + OFF_IW);
    LAS bf16_t* qs = (LAS bf16_t*)((LAS unsigned char*)lds);
    {
        const int row = tid >> 4, c = tid & 15;
        const bf16_t* src = IQ + (size_t)(qrow0 + row) * 1024 + c * 64;
        u32x4 t[8];
#pragma unroll
        for (int e = 0; e < 8; ++e) t[e] = *(const u32x4*)(src + 8 * e);
#pragma unroll
        for (int e = 0; e < 8; ++e) *(LAS u32x4*)(qs + row * 1032 + c * 64 + 8 * e) = t[e];
    }
    const int kt = 8 * j + 1 + w;
    bf16x8 ka[4][4];
    if (kt <= m) {
#pragma unroll
        for (int mt = 0; mt < 4; ++mt)
#pragma unroll
            for (int kk = 0; kk < 4; ++kk) ka[mt][kk] = *(const bf16x8*)(IK + (size_t)(128 * kt + 32 * mt + (lane & 31)) * 64 + kk * 16 + 8 * (lane >> 5));
    }
    __syncthreads();
    if (kt > m) return;
    f32x16 acc[4];
#pragma unroll
    for (int mt = 0; mt < 4; ++mt)
#pragma unroll
        for (int i = 0; i < 16; ++i) acc[mt][i] = 0.f;
    const float* wp = IW + (size_t)(qrow0 + (lane & 31)) * 16;
    const LAS bf16_t* qfr = qs + (lane & 31) * 1032 + 8 * (lane >> 5);
#define IDX_CHAIN(dst, mt, qq) do { _Pragma("unroll") for (int i = 0; i < 16; ++i) dst[i] = 0.f; _Pragma("unroll") for (int kk = 0; kk < 4; ++kk) dst = mfma32(ka[mt][kk], qq[kk], dst); } while (0)
#define IDX_ACC(src, mt, wv) do { } while (0)
#define IDX_STEP(dstC, mtC, qq, srcA, mtA, wv) do { _Pragma("unroll") for (int kk = 0; kk < 4; ++kk) { \
        if (kk == 0) { _Pragma("unroll") for (int i = 0; i < 16; ++i) dstC[i] = 0.f; } \
        dstC = mfma32(ka[mtC][kk], qq[kk], dstC); __builtin_amdgcn_sched_barrier(0); \
        _Pragma("unroll") for (int i = 0; i < 4; ++i) acc[mtA][4 * kk + i] += wv * __int_as_float(max(__float_as_int(srcA[4 * kk + i]), 0)); \
        __builtin_amdgcn_sched_barrier(0); } } while (0)
    bf16x8 qv[4], qx[4]; f32x16 sA, sB;
    float wh = wp[0];
#pragma unroll
    for (int kk = 0; kk < 4; ++kk) qv[kk] = *(const LAS bf16x8*)(qfr + kk * 16);
    IDX_CHAIN(sA, 0, qv);
#pragma unroll 1
    for (int h = 0; h < 16; ++h) {
        const int hn = h < 15 ? h + 1 : 15;
        const float wnx = wp[hn];
#pragma unroll
        for (int kk = 0; kk < 4; ++kk) qx[kk] = *(const LAS bf16x8*)(qfr + hn * 64 + kk * 16);
        IDX_STEP(sB, 1, qv, sA, 0, wh);
        IDX_STEP(sA, 2, qv, sB, 1, wh);
        IDX_STEP(sB, 3, qv, sA, 2, wh);
        IDX_STEP(sA, 0, qx, sB, 3, wh);
#pragma unroll
        for (int kk = 0; kk < 4; ++kk) qv[kk] = qx[kk];
        wh = wnx;
    }
#undef IDX_STEP
#undef IDX_CHAIN
#undef IDX_ACC
    int ln2 = lane; asm volatile("" : "+v"(ln2));
    float* dst = (float*)(a.ws + OFF_SC) + (size_t)(qb * qb + kt - 1) * 32768 + (size_t)((qrow0 & 255) + (ln2 & 31)) * 128 + 4 * (ln2 >> 5);
#pragma unroll
    for (int mt = 0; mt < 4; ++mt)
#pragma unroll
        for (int i4 = 0; i4 < 4; ++i4) { if (MODE == 0 || acc[mt][4 * i4] == 12345.678f) __builtin_nontemporal_store((f32x4){acc[mt][4 * i4], acc[mt][4 * i4 + 1], acc[mt][4 * i4 + 2], acc[mt][4 * i4 + 3]}, (f32x4*)(dst + 32 * mt + 8 * i4)); }
}

template <int N, int STRIDE>
FI unsigned bisect_keys(const unsigned (&key)[N], int target, bool& exact) {
    unsigned prefix = 0u; exact = false;
#pragma unroll 1
    for (int bit = 31; bit >= 0; --bit) {
        const unsigned cand = prefix | (1u << bit);
        int cnt = 0;
#pragma unroll
        for (int i = 0; i < N; i += STRIDE) { cnt += __popcll(__ballot(key[i] >= cand)); if (((i / STRIDE) & 7) == 7) __builtin_amdgcn_sched_barrier(0); }
        if (cnt >= target) { prefix = cand; if (cnt == target) { exact = true; break; } }
    }
    return prefix;
}
template <int NJ>
FI void topk_row(const Args& a, int rq, int lane, unsigned* cand_k, int* cand_i) {
    const int qb = rq >> 8;
    const float* SC = (const float*)(a.ws + OFF_SC);
    int* IDX = (int*)(a.ws + OFF_IDX) + (size_t)rq * 256; int* CNT = (int*)(a.ws + OFF_CNT);
    unsigned key[NJ * 4];
    {
        const float* rowp = SC + (size_t)(qb * qb) * 32768 + (size_t)(rq & 255) * 128 + 4 * (lane & 31) + (size_t)(lane >> 5) * 32768;
        const int ktmax = 2 * qb + 1 - (lane >> 5);
#pragma unroll
        for (int j = 0; j < NJ; ++j) {
            const int jj = (1 + 2 * j <= ktmax) ? j : 0;
            const u32x4 v = __builtin_nontemporal_load((const u32x4*)(rowp + (size_t)jj * 65536));
            key[4 * j] = v.x; key[4 * j + 1] = v.y; key[4 * j + 2] = v.z; key[4 * j + 3] = v.w;
        }
        __builtin_amdgcn_sched_barrier(0);
#pragma unroll
        for (int j = 0; j < NJ; ++j) {
            const int k0 = 128 * (1 + 2 * j + (lane >> 5)) + 4 * (lane & 31);
#pragma unroll
            for (int e = 0; e < 4; ++e) { const unsigned u = key[4 * j + e]; const unsigned m = (u & 0x80000000u) ? ~u : (u | 0x80000000u);
                const int kr = k0 + e; key[4 * j + e] = (kr >= ROW0 && kr <= rq) ? m : 0u; }
            if ((j & 3) == 3) __builtin_amdgcn_sched_barrier(0);
        }
    }
    const int n = rq - ROW0 + 1, want = n < 256 ? n : 256;
    int ln2 = lane; asm volatile("" : "+v"(ln2));
    const unsigned long long ltmask = (1ull << ln2) - 1ull;
    const int kbase = 128 * (1 + (ln2 >> 5)) + 4 * (ln2 & 31);
    bool done = false;
    if (n > 256) {
        bool ex; unsigned Ts = bisect_keys<NJ * 4, 8>(key, 48, ex);
        if (Ts == 0u) Ts = 1u;
        Ts = (unsigned)__builtin_amdgcn_readfirstlane((int)Ts);
        int c = 0;
#pragma unroll
        for (int i = 0; i < NJ * 4; ++i) { c += __popcll(__ballot(key[i] >= Ts)); if ((i & 7) == 7) __builtin_amdgcn_sched_barrier(0); }
        if (c >= 256 && c <= 512) {
            asm volatile("" : "+s"(Ts));
            int base = 0;
#pragma unroll
            for (int i = 0; i < NJ * 4; ++i) {
                const bool pr = key[i] >= Ts; const unsigned long long mk = __ballot(pr);
                if (pr) { const int pos = base + __popcll(mk & ltmask); cand_k[pos] = key[i]; cand_i[pos] = kbase + 256 * (i >> 2) + (i & 3); }
                base += __popcll(mk);
                if ((i & 3) == 3) __builtin_amdgcn_sched_barrier(0);
            }
            asm volatile("s_waitcnt lgkmcnt(0)" ::: "memory");
            unsigned ck[8]; int ci[8];
#pragma unroll
            for (int r = 0; r < 8; ++r) { const int p = ln2 + 64 * r; ck[r] = p < c ? cand_k[p] : 0u; ci[r] = p < c ? cand_i[p] : 0; }
            bool exact; const unsigned pre = bisect_keys<8, 1>(ck, 256, exact);
            const unsigned P = exact ? pre - 1u : pre;
            int ob = 0;
#pragma unroll
            for (int r = 0; r < 8; ++r) { const bool pr = ck[r] > P; const unsigned long long mk = __ballot(pr);
                if (pr) IDX[ob + __popcll(mk & ltmask)] = ci[r];
                ob += __popcll(mk); }
            if (ob < 256) {
#pragma unroll
                for (int r = 0; r < 8; ++r) { const bool pr = ck[r] == P; const unsigned long long mk = __ballot(pr);
                    const int pos = ob + __popcll(mk & ltmask);
                    if (pr && pos < 256) IDX[pos] = ci[r];
                    ob += __popcll(mk); }
            }
            done = true;
        }
    }
    if (!done) {
        unsigned P = 0u;
        if (n > 256) { bool exact; const unsigned pre = bisect_keys<NJ * 4, 1>(key, 256, exact); P = exact ? pre - 1u : pre; }
        int base = 0;
#pragma unroll
        for (int i = 0; i < NJ * 4; ++i) {
            const bool pr = key[i] > P; const unsigned long long mk = __ballot(pr);
            if (pr) IDX[base + __popcll(mk & ltmask)] = kbase + 256 * (i >> 2) + (i & 3);
            base += __popcll(mk);
            if ((i & 3) == 3) __builtin_amdgcn_sched_barrier(0);
        }
        if (base < want) {
#pragma unroll
            for (int i = 0; i < NJ * 4; ++i) {
                const bool pr = key[i] == P; const unsigned long long mk = __ballot(pr);
                const int pos = base + __popcll(mk & ltmask);
                if (pr && pos < want) IDX[pos] = kbase + 256 * (i >> 2) + (i & 3);
                base += __popcll(mk);
                if ((i & 3) == 3) __builtin_amdgcn_sched_barrier(0);
            }
        }
    }
    if (lane == 0) CNT[rq] = want;
}
FI void topk_item(const Args& a, int item, unsigned char* lds) {
    const int tid = tid_l(), lane = tid & 63, w = tid >> 6;
    const int rq = MR - 1 - item;
    if (rq < ROW0) return;
    unsigned* ck = (unsigned*)(lds + w * 4096); int* ci = (int*)(lds + w * 4096 + 2048);
    const int qb = rq >> 8;
    if (qb < 8) topk_row<8>(a, rq, lane, ck, ci);
    else if (qb < 16) topk_row<16>(a, rq, lane, ck, ci);
    else if (qb < 24) topk_row<24>(a, rq, lane, ck, ci);
    else topk_row<33>(a, rq, lane, ck, ci);
}

template <int ATTV>
FI void attn_item(const Args& a, int item, unsigned char* lds) {
    const int tid = tid_l(), lane = tid & 63, w = tid >> 6;
    const int rq = ROW0 + (item >> 1), g = item & 1;
    LAS unsigned char* sl = (LAS unsigned char*)lds + w * 16384;
    LAS float* Pw = (LAS float*)sl; LAS int* Iw = (LAS int*)(sl + 4096);
    LAS bf16_t* Pb = (LAS bf16_t*)(sl + 5120);
    LAS bf16_t* Vs = (LAS bf16_t*)(sl + 7168);
    const bf16_t* Q = (const bf16_t*)(a.ws + OFF_Q); const bf16_t* K = (const bf16_t*)(a.ws + OFF_K); const bf16_t* V = (const bf16_t*)(a.ws + OFF_V);
    const bf16_t* AG = (const bf16_t*)(a.ws + OFF_AG); bf16_t* MIX = (bf16_t*)(a.ws + OFF_MIX);
    const int* IDX = (const int*)(a.ws + OFF_IDX) + (size_t)rq * 256;
    const int cnt = ((const int*)(a.ws + OFF_CNT))[rq];
#pragma unroll
    for (int i = 0; i < 4; ++i) { const int k = lane + 64 * i; Iw[k] = k < cnt ? IDX[k] : rq; }
    asm volatile("s_waitcnt lgkmcnt(0)" ::: "memory");
    const int hq = lane & 15, quad = lane >> 4;
    bf16x8 bq[4];
#pragma unroll
    for (int kk = 0; kk < 4; ++kk) { bq[kk] = (bf16x8){0, 0, 0, 0, 0, 0, 0, 0};
        if (hq < 4) bq[kk] = *(const bf16x8*)(Q + (size_t)rq * 1024 + (4 * g + hq) * 128 + kk * 32 + 8 * quad); }
    const float scale = 0.08838834764831845f;
    const bf16_t* kbase = K + g * 128 + 8 * quad;
    LAS float* pwl = Pw + 16 * quad + hq; asm volatile("" : "+v"(pwl));
    const LAS int* iwl = Iw + hq; asm volatile("" : "+v"(iwl));
    LAS float* pws = Pw + 4 * (lane >> 2) + (lane & 3); asm volatile("" : "+v"(pws));
    {
        bf16x8 kA[4][4], kB[4][4];
#define ATT_LOADK(dst, tg) do { _Pragma("unroll") for (int t = 0; t < 4; ++t) { const bf16_t* kp = kbase + (size_t)iwl[(tg) * 64 + t * 16] * 256; \
            _Pragma("unroll") for (int kk = 0; kk < 4; ++kk) dst[t][kk] = *(const bf16x8*)(kp + kk * 32); } } while (0)
#define ATT_QK(src, tg) do { _Pragma("unroll") for (int t = 0; t < 4; ++t) { f32x4 sc4 = (f32x4){0.f, 0.f, 0.f, 0.f}; \
            _Pragma("unroll") for (int kk = 0; kk < 4; ++kk) sc4 = mfma16(src[t][kk], bq[kk], sc4); \
            if (hq < 4) { _Pragma("unroll") for (int i = 0; i < 4; ++i) { const int key = ((tg) * 4 + t) * 16 + 4 * quad + i; pwl[(((tg) * 4 + t) * 16 + i) * 4] = (key < cnt) ? sc4[i] * scale : -INFINITY; } } } } while (0)
        ATT_LOADK(kA, 0);
        ATT_LOADK(kB, 1); ATT_QK(kA, 0); __builtin_amdgcn_sched_barrier(0);
        ATT_LOADK(kA, 2); ATT_QK(kB, 1); __builtin_amdgcn_sched_barrier(0);
        ATT_LOADK(kB, 3); ATT_QK(kA, 2); __builtin_amdgcn_sched_barrier(0);
        ATT_QK(kB, 3);
#undef ATT_LOADK
#undef ATT_QK
    }
    const bf16_t* vb = V + g * 128 + 8 * hq;
    u32x4 vr[4][8];
#define ATT_LOADV(c) do { _Pragma("unroll") for (int j = 0; j < 8; ++j) { const int kr = Iw[(c) * 32 + 4 * j + quad]; vr[(c) & 3][j] = *(const u32x4*)(vb + (size_t)kr * 256); } } while (0)
    ATT_LOADV(0); ATT_LOADV(1); ATT_LOADV(2);
    asm volatile("s_waitcnt lgkmcnt(0)" ::: "memory");
    float sum = 0.f;
    {
        float lg[16]; float mx = -INFINITY;
#pragma unroll
        for (int m = 0; m < 16; ++m) { lg[m] = pws[64 * m]; mx = fmaxf(mx, lg[m]); }
        mx = fmaxf(mx, __shfl_xor(mx, 4)); mx = fmaxf(mx, __shfl_xor(mx, 8)); mx = fmaxf(mx, __shfl_xor(mx, 16)); mx = fmaxf(mx, __shfl_xor(mx, 32));
        LAS bf16_t* pbs = Pb + (lane & 3) * 256 + (lane >> 2);
#pragma unroll
        for (int m = 0; m < 16; ++m) { const float p = __expf(lg[m] - mx); const bf16_t pb = f2bf(p); sum += bf2f(pb); pbs[16 * m] = pb; }
        sum += __shfl_xor(sum, 4); sum += __shfl_xor(sum, 8); sum += __shfl_xor(sum, 16); sum += __shfl_xor(sum, 32);
    }
    asm volatile("s_waitcnt lgkmcnt(0)" ::: "memory");
    f32x4 acc[8];
#pragma unroll
    for (int t = 0; t < 8; ++t) acc[t] = (f32x4){0.f, 0.f, 0.f, 0.f};
    const LAS bf16_t* pa_p = Pb + (lane & 3) * 256 + 8 * quad;
    const LAS bf16_t* vrd = Vs + (8 * quad) * 136 + hq;
    LAS bf16_t* vwr = Vs + quad * 136 + 8 * hq;
#pragma unroll
    for (int c = 0; c < 8; ++c) {
        asm volatile("" ::: "memory");
#pragma unroll
        for (int j = 0; j < 8; ++j) *(LAS u32x4*)(vwr + (4 * j) * 136) = vr[c & 3][j];
        asm volatile("" ::: "memory");
        if (c + 3 < 8) ATT_LOADV(c + 3);
        __builtin_amdgcn_sched_barrier(0);
        const bf16x8 pa = *(const LAS bf16x8*)(pa_p + c * 32);
#pragma unroll
        for (int t = 0; t < 8; ++t) {
            bf16x8 bv;
#pragma unroll
            for (int j = 0; j < 8; ++j) bv[j] = (short)vrd[j * 136 + 16 * t];
            acc[t] = mfma16(pa, bv, acc[t]);
        }
    }
#undef ATT_LOADV
    asm volatile("s_waitcnt lgkmcnt(0)" ::: "memory");
    if (quad == 0) {
#pragma unroll
        for (int t = 0; t < 8; ++t)
#pragma unroll
            for (int i = 0; i < 4; ++i) Pw[i * 128 + 16 * t + hq] = acc[t][i];
    }
    asm volatile("s_waitcnt lgkmcnt(0)" ::: "memory");
    const float isum = 1.f / __shfl(sum, quad);
    int ln3 = lane; asm volatile("" : "+v"(ln3));
    const int hd = ln3 >> 4, d0 = 8 * (ln3 & 15);
    const f32x4 o0 = *(const LAS f32x4*)(Pw + hd * 128 + d0), o1 = *(const LAS f32x4*)(Pw + hd * 128 + d0 + 4);
    float r[8] = {o0.x, o0.y, o0.z, o0.w, o1.x, o1.y, o1.z, o1.w};
    const int col = (4 * g + hd) * 128 + d0;
    float gt[8]; unpack8(*(const u32x4*)(AG + (size_t)rq * 1024 + col), gt);
#pragma unroll
    for (int e = 0; e < 8; ++e) r[e] *= isum * gt[e];
    if (ATTV == 0 || r[0] == 12345.678f) *(u32x4*)(MIX + (size_t)rq * DMIX + 3072 + col) = pack8(r);
}

#define XB_TMO      128
#define XB_XCNT(j)  (256  + 64 * (j))
#define XB_XSUB(j)  (1280 + 64 * (j))
#define XB_XGEN(j)  (2304 + 64 * (j))
#define XB_TOP      3328
#define XB_TOPGEN   3392
#define XCD_BAR_WORDS 3456
#define XB_SPIN_CAP (1u << 20)
static_assert(OFF_BAR + XCD_BAR_WORDS * 4 <= CTL_BYTES, "barrier words inside the memset region");
FI unsigned xb_ld(unsigned* p)              { return __hip_atomic_load(p, __ATOMIC_RELAXED, __HIP_MEMORY_SCOPE_AGENT); }
FI unsigned xb_add(unsigned* p, unsigned v) { return __hip_atomic_fetch_add(p, v, __ATOMIC_RELAXED, __HIP_MEMORY_SCOPE_AGENT); }
FI unsigned xb_xcc_id() { return (unsigned)__builtin_amdgcn_s_getreg((3 << 11) | 20) & 0xFu; }
#define XB_SPIN(cond, bar) do { unsigned _sp = 0; while (cond) { __builtin_amdgcn_s_sleep(1); \
    if ((++_sp & 255u) == 0u) { if (xb_ld(&(bar)[XB_TMO])) break; if (_sp > XB_SPIN_CAP) { atomicAdd(&(bar)[XB_TMO], 1u); break; } } } } while (0)
FI void xcd_barrier_complete(unsigned* bar, unsigned x, unsigned& nloc, unsigned& nx) {
    const unsigned G = gridDim.x;
    unsigned sum, cnt, mine, sp = 0u;
    for (;;) {
        sum = 0u; cnt = 0u; mine = 0u;
#pragma unroll
        for (unsigned j = 0; j < 16; ++j) { const unsigned c = xb_ld(&bar[XB_XCNT(j)]); sum += c; cnt += (c > 0u) ? 1u : 0u; mine = (j == x) ? c : mine; }
        if (sum == G) break;
        __builtin_amdgcn_s_sleep(1);
        if ((++sp & 255u) == 0u) { if (xb_ld(&bar[XB_TMO])) break; if (sp > XB_SPIN_CAP) { atomicAdd(&bar[XB_TMO], 1u); break; } }
    }
    nloc = mine > 0u ? mine : 1u; nx = cnt > 0u ? cnt : 1u;
}
FI void xcd_barrier(unsigned* bar, volatile LAS unsigned* st) {
    asm volatile("s_waitcnt vmcnt(0)" ::: "memory");
    __syncthreads();
    if (tid_l() == 0) {
        const unsigned x = xb_xcc_id();
        __builtin_amdgcn_s_waitcnt(0);
        unsigned nloc = st[0], nx = st[1];
        if (nloc == 0u) { xcd_barrier_complete(bar, x, nloc, nx); st[0] = nloc; st[1] = nx; }
        const unsigned old = xb_add(&bar[XB_XSUB(x)], 1u);
        const unsigned gen = old / nloc;
        if (old + 1u == (gen + 1u) * nloc) {
            __builtin_amdgcn_fence(__ATOMIC_RELEASE, "agent");
            asm volatile("s_waitcnt vmcnt(0)" ::: "memory");
            const unsigned og = xb_add(&bar[XB_TOP], 1u);
            const unsigned tg = og / nx;
            if (og + 1u == (tg + 1u) * nx) xb_add(&bar[XB_TOPGEN], 1u);
            else XB_SPIN(xb_ld(&bar[XB_TOPGEN]) == tg, bar);
            __builtin_amdgcn_fence(__ATOMIC_ACQUIRE, "agent");
            xb_add(&bar[XB_XGEN(x)], 1u);
            asm volatile("s_waitcnt vmcnt(0)" ::: "memory");
        } else {
            XB_SPIN(xb_ld(&bar[XB_XGEN(x)]) == gen, bar);
            __builtin_amdgcn_fence(__ATOMIC_ACQUIRE, "agent");
            asm volatile("s_waitcnt vmcnt(0)" ::: "memory");
        }
    }
    __syncthreads();
}
#define GRID_BAR() do { const Args _ab = load_args(); xcd_barrier((unsigned*)(_ab.ws + OFF_BAR), xst); } while (0)

FI void meta_rows_out(const Args& a) {
    const int tid = tid_l(), lane = tid & 63, w = tid >> 6;
    if (w != 0 || blockIdx.x >= 128) return;
    const bf16_t* A = (const bf16_t*)(a.ws + OFF_MIX) + (size_t)(ROW0 + (lane & 15)) * DMIX + 8 * (lane >> 4);
    const bf16_t* B = (const bf16_t*)(a.ws + OFF_WOUT) + (size_t)(16 * blockIdx.x + (lane & 15)) * DMIX + 8 * (lane >> 4);
    f32x4 acc0 = (f32x4){0.f, 0.f, 0.f, 0.f}, acc1 = acc0;
#pragma unroll 1
    for (int k0 = 0; k0 < DMIX; k0 += 512) {
        bf16x8 av[16], bv[16];
#pragma unroll
        for (int j = 0; j < 16; ++j) { av[j] = *(const bf16x8*)(A + k0 + 32 * j); bv[j] = *(const bf16x8*)(B + k0 + 32 * j); }
#pragma unroll
        for (int j = 0; j < 16; j += 2) { acc0 = mfma16(av[j], bv[j], acc0); acc1 = mfma16(av[j + 1], bv[j + 1], acc1); }
    }
    float* O = (float*)(a.ws + OFF_OUT);
#pragma unroll
    for (int i = 0; i < 4; ++i) O[(size_t)(ROW0 + 4 * (lane >> 4) + i) * DM + 16 * blockIdx.x + (lane & 15)] = acc0[i] + acc1[i];
}

#ifndef PHM
#define PHM 0xffff
#endif
#define DBL 0
#define ATTVAR 0
__global__ void __launch_bounds__(512, 2) fwd(Args a_unused) {
    extern __shared__ __attribute__((aligned(16))) unsigned char lds[];
    cg::grid_group grid = cg::this_grid();
    LAS unsigned char* ldsl = (LAS unsigned char*)lds;
    LAS int* slot = (LAS int*)(ldsl + LDS_BYTES - 16);

    volatile LAS unsigned* xst = (volatile LAS unsigned*)(ldsl + LDS_BYTES - 32);
    if (tid_l() < 2) xst[tid_l()] = 0u;
    __syncthreads();
    if (tid_l() == 0) { const Args a = load_args(); (void)xb_add((unsigned*)(a.ws + OFF_BAR) + XB_XCNT(xb_xcc_id()), 1u); }
    if (PHM & 1) {
        { const Args a = load_args(); rope_tables(a); }
        { const Args a = load_args(); convert_weights(a, 0, lds); }
        if (DBL & 256) { const Args a = load_args(); convert_weights(a, 0, lds); }
        { const Args a = load_args(); convert_pool_w(a, lds); }
        { const Args a = load_args(); row_pass(a, 0, 0); }
    }
    grid.sync();

    for (int layer = 0; layer < 2; ++layer) {
        if (PHM & 2) {
            const Args a = load_args();
            pg8::Gemm g{(const bf16_t*)(a.ws + OFF_U), (const bf16_t*)(a.ws + OFF_WIN), MR, NP, DM};
            pg8::StaticOrder S; S.init(MR, NP, DM, (int)gridDim.x, (int)blockIdx.x);
            Epi1 E{a.ws, a.in[9] + layer * 32};
            pg8::gemm_phase<Epi1, pg8::StaticOrder, true, true>(ldsl, g, S, E);
            if (DBL & 64) { __syncthreads(); pg8::gemm_phase<Epi1, pg8::StaticOrder, true, true>(ldsl, g, S, E); }
        }
        GRID_BAR();
        {
            int nxt = 0;
            for (;;) {
                const Args a = load_args();
                const int it = next_item((unsigned*)(a.ws + OFF_CTL) + layer * 8 + 0, slot, nxt, 0);
                if (it < 260) ssd_s1(a, layer, it >> 2, it & 3, lds);
                else if (it < 260 + IDX_BLOCK_TASKS) indexer_block_task<0>(a, it - 260, lds);
                else if (it < 260 + IDX_BLOCK_TASKS + 264) pool_pre_item(a, it - 260 - IDX_BLOCK_TASKS);
                else break;
            }
#ifdef PROBE_IDX
            nxt = 0;
            for (;;) {
                const Args a = load_args();
                const int it = next_item((unsigned*)(a.ws + OFF_CTL) + layer * 8 + 6, slot, nxt, 0);
                if (it < IDX_BLOCK_TASKS) indexer_block_task<PROBE_IDX>(a, it, lds);
                else break;
            }
#endif
        }
        GRID_BAR();
        if (PHM & 32) {
            const Args a = load_args();
            pg8::Gemm g{(const bf16_t*)(a.ws + OFF_U), (const bf16_t*)(a.ws + OFF_PWT) + (size_t)layer * 4 * 65536, 4 * MR, 256, 256};
            pg8::PoolOrder S{(int)gridDim.x, (int)blockIdx.x};
            EpiPool E{(bf16_t*)(a.ws + OFF_MIX), (const bf16_t*)(a.ws + OFF_PG), a.in[6] + layer * 1024};
            pg8::gemm_phase<EpiPool, pg8::PoolOrder, false, true>(ldsl, g, S, E);
        }
        {
            int nxt = 0;
            for (;;) {
                const Args a = load_args();
                const int it = next_item((unsigned*)(a.ws + OFF_CTL) + layer * 8 + 1, slot, nxt, 0);
                if (it < 128) ssd_scan_item(a, it);
                else break;
            }
            const int lane = tid_l() & 63;
            const int wq = __builtin_amdgcn_readfirstlane(tid_l() >> 6);
            int nv = wave_fetch((unsigned*)(load_args().ws + OFF_CTL + 20480) + ((layer * 3 + 1) * 8 + wq) * 64, lane);
            for (;;) {
                const Args a = load_args();
                const int it = 8 * __builtin_amdgcn_readfirstlane(nv) + wq;
                if (it >= NTOK) break;
                nv = wave_fetch((unsigned*)(a.ws + OFF_CTL + 20480) + ((layer * 3 + 1) * 8 + wq) * 64, lane);
                topk_item(a, it, lds);
            }
        }
        GRID_BAR();
        {
            int nxt = 0;
            for (;;) {
                const Args a = load_args();
                const int it = next_item((unsigned*)(a.ws + OFF_CTL) + layer * 8 + 2, slot, nxt, 0);
                if (it < 260) ssd_s3(a, layer, it >> 2, it & 3, lds);
                else break;
            }
            __syncthreads();
            const int lane = tid_l() & 63;
            const int wq = __builtin_amdgcn_readfirstlane(tid_l() >> 6);
            int nv = wave_fetch((unsigned*)(load_args().ws + OFF_CTL + 20480) + ((layer * 3 + 2) * 8 + wq) * 64, lane);
            for (;;) {
                const Args a = load_args();
                const int it = 8 * __builtin_amdgcn_readfirstlane(nv) + wq;
                if (it >= NTOK * 2) break;
                nv = wave_fetch((unsigned*)(a.ws + OFF_CTL + 20480) + ((layer * 3 + 2) * 8 + wq) * 64, lane);
                attn_item<0>(a, it, lds);
            }
        }
        GRID_BAR();
        if (PHM & 1024) {
            const Args a = load_args();
            const int skip = 256;
            pg8::Gemm g{(const bf16_t*)(a.ws + OFF_MIX) + (size_t)skip * DMIX, (const bf16_t*)(a.ws + OFF_WOUT), MR - skip, DM, DMIX};
            pg8::StaticOrder S; S.init(MR - skip, DM, DMIX, (int)gridDim.x, (int)blockIdx.x);
            EpiOut E{(float*)(a.ws + OFF_OUT), skip};
            pg8::gemm_phase<EpiOut, pg8::StaticOrder, false, true>(ldsl, g, S, E);
            if (DBL & 128) { __syncthreads(); pg8::gemm_phase<EpiOut, pg8::StaticOrder, false, true>(ldsl, g, S, E); }
            if (layer == 0) meta_rows_out(a);
        }
        GRID_BAR();
        if (PHM & 2048) {
            if (layer == 0) { { const Args a = load_args(); row_pass(a, 1, 0); } { const Args a = load_args(); convert_weights(a, 1, lds); } }
            else { const Args a = load_args(); row_pass(a, 2, 1); }
        }
        if (layer == 0) GRID_BAR();
    }
}

extern "C" void kernel_launch(void* const* d_in, const int* in_sizes, int n_in, void* d_out, int out_size, void* d_ws, size_t ws_size, hipStream_t stream) {
    static int grid = 0;
    if (grid == 0) {
        int dev = 0, cus = 0, per_cu = 0;
        (void)hipGetDevice(&dev); (void)hipDeviceGetAttribute(&cus, hipDeviceAttributeMultiprocessorCount, dev);
        (void)hipFuncSetAttribute((const void*)fwd, hipFuncAttributeMaxDynamicSharedMemorySize, LDS_BYTES);
        (void)hipOccupancyMaxActiveBlocksPerMultiprocessor(&per_cu, (const void*)fwd, 512, LDS_BYTES);
        if (ws_size < WS_END || n_in != 14) { fprintf(stderr, "kernel_launch: ws_size %zu < %zu or n_in %d != 14\n", ws_size, (size_t)WS_END, n_in); grid = -1; return; }
        grid = cus > 0 ? cus : 256;
        (void)per_cu;
    }
    if (grid < 0) return;
    (void)hipMemsetAsync((char*)d_ws + OFF_CTL, 0, CTL_BYTES, stream);
    Args a{};
    for (int i = 0; i < 14; ++i) a.in[i] = (const float*)d_in[i];
    a.out = (float*)d_out; a.ws = (unsigned char*)d_ws;
    void* args[] = {&a};
    hipError_t e = hipLaunchCooperativeKernel((void*)fwd, dim3(grid), dim3(512), args, LDS_BYTES, stream);
    if (e != hipSuccess) fprintf(stderr, "cooperative launch failed: %s (grid %d)\n", hipGetErrorString(e), grid);
}
```

```cpp
#include <hip/hip_runtime.h>
#include <hip/hip_cooperative_groups.h>
#include <cstdio>
#include <cstdint>
#include <cmath>
namespace cg = cooperative_groups;

typedef unsigned short bf16_t;
typedef short bf16x8 __attribute__((ext_vector_type(8)));
typedef float f32x4 __attribute__((ext_vector_type(4)));
typedef float f32x16 __attribute__((ext_vector_type(16)));
typedef unsigned u32x4 __attribute__((ext_vector_type(4)));
typedef unsigned u32x2 __attribute__((ext_vector_type(2)));
#define LAS __attribute__((address_space(3)))
#define FI __device__ __forceinline__

constexpr int MR = 8448;
constexpr int ROW0 = 240;
constexpr int NTOK = 8208;
constexpr int DM = 2048;
constexpr int NP = 11008;
constexpr int DMIX = 4096;
constexpr int NCH = 65;
constexpr float EPS = 1e-6f;
constexpr int LDS_BYTES = 147456;

constexpr size_t OFF_CTL = 0;
constexpr size_t OFF_BAR = 4096;
constexpr size_t CTL_BYTES = 32768;
constexpr size_t OFF_WIN = CTL_BYTES;
constexpr size_t OFF_WOUT = OFF_WIN + (size_t)NP * DM * 2;
constexpr size_t OFF_PWT = OFF_WOUT + (size_t)DM * DMIX * 2;
constexpr size_t OFF_ROPEA = OFF_PWT + (size_t)2 * 4 * 65536 * 2;
constexpr size_t OFF_ROPEI = OFF_ROPEA + (size_t)MR * 16 * 4 * 2;
constexpr size_t OFF_H = OFF_ROPEI + (size_t)MR * 8 * 4 * 2;
constexpr size_t OFF_U = OFF_H + (size_t)MR * DM * 4;
constexpr size_t OFF_PG = OFF_U + (size_t)MR * DM * 2;
constexpr size_t OFF_ZS = OFF_PG + (size_t)MR * 1024 * 2;
constexpr size_t OFF_XBC = OFF_ZS + (size_t)MR * 2048 * 2;
constexpr size_t OFF_PV = OFF_XBC + (size_t)MR * 3072 * 2;
constexpr size_t OFF_MIX = OFF_XBC;
constexpr size_t OFF_DT = OFF_PV + (size_t)MR * 1024 * 2;
constexpr size_t OFF_Q = OFF_DT + (size_t)MR * 32 * 4;
constexpr size_t OFF_K = OFF_Q + (size_t)MR * 1024 * 2;
constexpr size_t OFF_V = OFF_K + (size_t)MR * 256 * 2;
constexpr size_t OFF_AG = OFF_V + (size_t)MR * 256 * 2;
constexpr size_t OFF_IQ = OFF_AG + (size_t)MR * 1024 * 2;
constexpr size_t OFF_IK = OFF_IQ + (size_t)MR * 1024 * 2;
constexpr size_t OFF_IW = OFF_IK + (size_t)MR * 64 * 2;
constexpr size_t OFF_XS = OFF_IW + (size_t)MR * 16 * 4;
constexpr size_t OFF_CM = OFF_XS + (size_t)MR * 2048 * 2;
constexpr size_t OFF_CSB = OFF_CM + (size_t)MR * 512 * 2;
constexpr size_t OFF_YD = OFF_CSB + (size_t)MR * 32 * 4;
constexpr size_t OFF_OUT = OFF_YD;
constexpr size_t OFF_HS = OFF_YD + (size_t)MR * 2048 * 2;
static_assert((size_t)NCH * 32 * 64 * 128 * 2 <= (size_t)MR * 2048 * 2, "HS fits behind the bf16 y_diag");
constexpr size_t OFF_ST = OFF_YD + (size_t)MR * 2048 * 4;
constexpr size_t OFF_CD = OFF_ST + (size_t)NCH * 32 * 64 * 128 * 4;
constexpr size_t OFF_SC = OFF_CD + 8448;
constexpr size_t OFF_IDX = OFF_SC + (size_t)1089 * 256 * 128 * 4;
constexpr size_t OFF_CNT = OFF_IDX + (size_t)MR * 256 * 4;
constexpr size_t WS_END = OFF_CNT + (size_t)MR * 4;
static_assert(OFF_PV + (size_t)MR * 1024 * 2 - OFF_XBC == (size_t)MR * DMIX * 2, "MIX alias");
static_assert(WS_END <= 711983104ull, "workspace");

struct Args { const float* in[14]; float* out; unsigned char* ws; };
__device__ __forceinline__ Args load_args() {
#if defined(__HIP_DEVICE_COMPILE__)
    const __attribute__((address_space(4))) Args* p = (const __attribute__((address_space(4))) Args*)__builtin_amdgcn_kernarg_segment_ptr();
    asm volatile("" : "+s"(p));
    Args r;
#pragma unroll
    for (int i = 0; i < 14; ++i) r.in[i] = p->in[i];
    r.out = p->out; r.ws = p->ws;
    return r;
#else
    return Args{};
#endif
}

FI unsigned cvt_pk_bf16(float lo, float hi) { unsigned r; asm volatile("v_cvt_pk_bf16_f32 %0, %1, %2" : "=v"(r) : "v"(lo), "v"(hi)); return r; }
FI bf16_t f2bf(float f) { return (bf16_t)(cvt_pk_bf16(f, 0.f) & 0xffffu); }
FI float bf2f(bf16_t h) { return __uint_as_float((unsigned)h << 16); }
FI float bflo(unsigned w) { return __uint_as_float(w << 16); }
FI float bfhi(unsigned w) { return __uint_as_float(w & 0xffff0000u); }
FI float silu_f(float x) { return x / (1.f + __expf(-x)); }
FI float wave_sum(float v) {
#pragma unroll
    for (int o = 1; o < 64; o <<= 1) v += __shfl_xor(v, o);
    return v;
}
FI void unpack8(u32x4 w, float* o) { o[0] = bflo(w.x); o[1] = bfhi(w.x); o[2] = bflo(w.y); o[3] = bfhi(w.y); o[4] = bflo(w.z); o[5] = bfhi(w.z); o[6] = bflo(w.w); o[7] = bfhi(w.w); }
FI u32x4 pack8(const float* v) { u32x4 w; w.x = cvt_pk_bf16(v[0], v[1]); w.y = cvt_pk_bf16(v[2], v[3]); w.z = cvt_pk_bf16(v[4], v[5]); w.w = cvt_pk_bf16(v[6], v[7]); return w; }
FI f32x16 mfma32(bf16x8 a, bf16x8 b, f32x16 c) { return __builtin_amdgcn_mfma_f32_32x32x16_bf16(a, b, c, 0, 0, 0); }
FI f32x4 mfma16(bf16x8 a, bf16x8 b, f32x4 c) { return __builtin_amdgcn_mfma_f32_16x16x32_bf16(a, b, c, 0, 0, 0); }

FI int tid_l() { int t = threadIdx.x; asm volatile("" : "+v"(t)); return t; }
FI int next_item(unsigned* ctr, LAS int* slot, int& nxt, int total) {
    __syncthreads();
    if (tid_l() == 0) *slot = (int)atomicAdd(ctr, 1u);
    __syncthreads();
    return *slot;
}
FI int wave_fetch(unsigned* ctr, int lane) { int v = 0; if (lane == 0) v = (int)atomicAdd(ctr, 1u); return v; }
FI int first_item(unsigned* ctr) { return 0; }

namespace pg8 {
constexpr int BM = 256, BK = 64, HALF = 128, HTB = HALF * BK * 2, STAGE_BYTES = 8 * HTB, NXCD = 8, WGM = 8;
FI int lds_byte(int r, int c) { const int st = (r >> 4) * 2 + (c >> 5), rr = r & 15, cc = c & 31, ob = rr * 64 + cc * 2; return st * 1024 + (ob ^ (((ob >> 9) & 1) << 5)); }
FI void stage_rc(int b, int& R, int& C) { const int st = b / 1024, sb = b % 1024, swz = sb ^ (((sb >> 9) & 1) << 5); R = (st >> 1) * 16 + swz / 64; C = (st & 1) * 32 + (swz % 64) / 2; }
FI int perm32(int rho) { const int n = rho >> 4, i = rho & 15; return 8 * (i >> 2) + 4 * n + (i & 3); }
struct Unit { int pm, pn; };
struct Gemm { const bf16_t* A; const bf16_t* Bt; int M, N, K; };

struct StaticOrder {
    int nM, nN, nwg, G, c, K;
    FI void init(int M, int N, int K_, int G_, int c_) { nM = M / BM; nN = N / BM; nwg = nM * nN; G = G_; c = c_; K = K_; }
    FI bool next(int i, Unit& u) const {
        const long L = (long)i * G + c; if (L >= nwg) return false;
        int wgid = (int)L; { const int q = nwg / NXCD, r = nwg % NXCD, xcd = wgid % NXCD, off = wgid / NXCD; wgid = (xcd < r ? xcd * (q + 1) : r * (q + 1) + (xcd - r) * q) + off; }
        const int nig = WGM * nN, gid = wgid / nig, fm = gid * WGM, gsz = (nM - fm) < WGM ? (nM - fm) : WGM;
        u.pm = fm + ((wgid % nig) % gsz); u.pn = (wgid % nig) / gsz; return true;
    }
    FI size_t aoff(const Unit& u) const { return (size_t)u.pm * 512 * K; }
    FI size_t boff(const Unit& u) const { return (size_t)u.pn * 512 * K; }
};
struct PoolOrder {
    int G, c;
    FI bool next(int i, Unit& u) const { const int L = i * G + c; if (L >= 132) return false; u.pm = L; u.pn = 0; return true; }
    FI size_t aoff(const Unit& u) const { return (size_t)u.pm * 512 * 256; }
    FI size_t boff(const Unit& u) const { return (size_t)(u.pm / 33) * 65536 * 2; }
};

template <class Epi, class Sched, bool ALIGN_EPI = false, bool SP2 = false>
FI void gemm_phase(LAS unsigned char* lds, const Gemm g, const Sched& S, const Epi& E) {
    const int tid = tid_l(), wid = __builtin_amdgcn_readfirstlane(tid >> 6), lane = tid & 63, wr = wid >> 2, wc = wid & 3, fr = lane & 15, fq = lane >> 4;
    const int K = g.K, nt = K / BK;
    unsigned voffA[2], voffB[2];
#pragma unroll
    for (int i = 0; i < 2; ++i) { int R, C; stage_rc(tid * 16 + i * 8192, R, C); const int Rb = Epi::PERM ? ((R & ~31) + perm32(R & 31)) : R;
        voffA[i] = (unsigned)(R * K + C) * 2u; voffB[i] = (unsigned)(Rb * K + C) * 2u; }
    const size_t kstep = (size_t)(BK * 2);
    const size_t hstep = (size_t)HALF * K * 2;
    const unsigned ldsw = (unsigned)wid * 1024u;
    const int aoff = lds_byte(wr * 64 + fr, fq * 8), boff = lds_byte(wc * 32 + fr, fq * 8);
#define PG8_SA(b, h) (((b) * 2 + (h)) * HTB)
#define PG8_SB(b, h) ((4 + (b) * 2 + (h)) * HTB)
#define PG8_STAGE(bufoff, gbase, voff) do { _Pragma("unroll") for (int _i = 0; _i < 2; ++_i) \
        __builtin_amdgcn_global_load_lds((const unsigned*)((const char*)(gbase) + (voff)[_i]), (LAS unsigned*)(lds + (bufoff) + ldsw + _i * 8192), 16, 0, 0); } while (0)
#define PG8_LDA(dst, b, h) do { _Pragma("unroll") for (int m = 0; m < 4; ++m) _Pragma("unroll") for (int k = 0; k < 2; ++k) dst[m][k] = *(const LAS bf16x8*)(lds + PG8_SA(b, h) + aoff + m * 2048 + k * 1024); } while (0)
#define PG8_LDB(dst, b, h) do { _Pragma("unroll") for (int n = 0; n < 2; ++n) _Pragma("unroll") for (int k = 0; k < 2; ++k) dst[n][k] = *(const LAS bf16x8*)(lds + PG8_SB(b, h) + boff + n * 2048 + k * 1024); } while (0)
#define PG8_MMA(ai, bj, At, Bt) do { __builtin_amdgcn_s_setprio(1); _Pragma("unroll") for (int m = 0; m < 4; ++m) _Pragma("unroll") for (int n = 0; n < 2; ++n) _Pragma("unroll") for (int k = 0; k < 2; ++k) \
        acc[ai][bj][m][n] = __builtin_amdgcn_mfma_f32_16x16x32_bf16(Bt[n][k], At[m][k], acc[ai][bj][m][n], 0, 0, 0); __builtin_amdgcn_s_setprio(0); } while (0)
#define PG8_WAIT_V(n) asm volatile("s_waitcnt vmcnt(" #n ")" ::: "memory")
#define PG8_WAIT_L(n) asm volatile("s_waitcnt lgkmcnt(" #n ")" ::: "memory")
#define PG8_BAR __builtin_amdgcn_s_barrier()
#define PG8_SCHED __builtin_amdgcn_sched_barrier(0)
    Unit cur, nxt; int ui = 0;
    if (!S.next(0, cur)) return;
    f32x4 acc[2][2][4][2];
#pragma unroll
    for (int a = 0; a < 2; ++a)
#pragma unroll
        for (int b = 0; b < 2; ++b)
#pragma unroll
            for (int m = 0; m < 4; ++m)
#pragma unroll
                for (int n = 0; n < 2; ++n) acc[a][b][m][n] = (f32x4){0.f, 0.f, 0.f, 0.f};
    bf16x8 At[4][2], B0[2][2], B1[2][2];
    const char* cA = (const char*)g.A + S.aoff(cur); const char* cB = (const char*)g.Bt + S.boff(cur);
    if constexpr (SP2) {
        PG8_STAGE(PG8_SB(0, 0), cB, voffB); PG8_STAGE(PG8_SB(0, 1), cB + hstep, voffB); PG8_STAGE(PG8_SA(0, 0), cA, voffA); PG8_STAGE(PG8_SA(0, 1), cA + hstep, voffA);
        if (wr == 1) PG8_BAR;
        PG8_WAIT_V(2); PG8_BAR;
        PG8_STAGE(PG8_SB(1, 0), cB + kstep, voffB); PG8_STAGE(PG8_SA(1, 0), cA + kstep, voffA); PG8_STAGE(PG8_SB(1, 1), cB + hstep + kstep, voffB);
        PG8_WAIT_V(6); PG8_BAR;
    } else {
    PG8_STAGE(PG8_SB(0, 0), cB, voffB); PG8_STAGE(PG8_SA(0, 0), cA, voffA); PG8_STAGE(PG8_SB(0, 1), cB + hstep, voffB); PG8_STAGE(PG8_SA(0, 1), cA + hstep, voffA);
    if (wr == 1) PG8_BAR;
    PG8_WAIT_V(4); PG8_BAR;
    PG8_STAGE(PG8_SB(1, 0), cB + kstep, voffB); PG8_STAGE(PG8_SA(1, 0), cA + kstep, voffA); PG8_STAGE(PG8_SB(1, 1), cB + hstep + kstep, voffB);
    PG8_WAIT_V(6); PG8_BAR;
    }
    for (;;) {
        const bool has_next = S.next(ui + 1, nxt);
        const char* nA = has_next ? (const char*)g.A + S.aoff(nxt) : cA; const char* nB = has_next ? (const char*)g.Bt + S.boff(nxt) : cB;
        for (int t = 0; t < nt; t += 2) {
            const bool last = (t == nt - 2);
            const char* a1 = cA + (size_t)(t + 1) * kstep;
            const char* a2 = last ? nA : cA + (size_t)(t + 2) * kstep; const char* b2 = last ? nB : cB + (size_t)(t + 2) * kstep;
            const char* a3 = a2 + kstep; const char* b3 = b2 + kstep;
            if constexpr (SP2) {
            PG8_LDB(B0, 0, 0); PG8_LDB(B1, 0, 1); PG8_SCHED; PG8_LDA(At, 0, 0); PG8_STAGE(PG8_SA(1, 1), a1 + hstep, voffA);
            PG8_WAIT_V(8); PG8_WAIT_L(0); PG8_BAR; PG8_MMA(0, 0, At, B0); PG8_MMA(0, 1, At, B1); PG8_BAR; PG8_SCHED;
            PG8_LDA(At, 0, 1); PG8_STAGE(PG8_SB(0, 0), b2, voffB); PG8_STAGE(PG8_SB(0, 1), b2 + hstep, voffB); PG8_STAGE(PG8_SA(0, 0), a2, voffA);
            PG8_WAIT_V(8); PG8_WAIT_L(0); PG8_BAR; PG8_MMA(1, 0, At, B0); PG8_MMA(1, 1, At, B1); PG8_BAR; PG8_SCHED;
            PG8_LDB(B0, 1, 0); PG8_LDB(B1, 1, 1); PG8_SCHED; PG8_LDA(At, 1, 0); PG8_STAGE(PG8_SA(0, 1), a2 + hstep, voffA);
            PG8_WAIT_V(8); PG8_WAIT_L(0); PG8_BAR; PG8_MMA(0, 0, At, B0); PG8_MMA(0, 1, At, B1); PG8_BAR; PG8_SCHED;
            PG8_LDA(At, 1, 1); PG8_STAGE(PG8_SB(1, 0), b3, voffB); PG8_STAGE(PG8_SB(1, 1), b3 + hstep, voffB); PG8_STAGE(PG8_SA(1, 0), a3, voffA);
            PG8_WAIT_V(8); PG8_WAIT_L(0); PG8_BAR; PG8_MMA(1, 0, At, B0); PG8_MMA(1, 1, At, B1); PG8_BAR; PG8_SCHED;
            } else {
            PG8_LDB(B0, 0, 0); PG8_SCHED; PG8_LDA(At, 0, 0); PG8_STAGE(PG8_SA(1, 1), a1 + hstep, voffA);
            PG8_WAIT_L(8); PG8_BAR; PG8_WAIT_L(0); PG8_MMA(0, 0, At, B0); PG8_BAR; PG8_SCHED;
            PG8_LDB(B1, 0, 1); PG8_STAGE(PG8_SB(0, 0), b2, voffB);
            PG8_BAR; PG8_WAIT_L(0); PG8_MMA(0, 1, At, B1); PG8_BAR;
            PG8_LDA(At, 0, 1); PG8_STAGE(PG8_SA(0, 0), a2, voffA);
            PG8_BAR; PG8_WAIT_L(0); PG8_MMA(1, 0, At, B0); PG8_BAR; PG8_SCHED;
            PG8_STAGE(PG8_SB(0, 1), b2 + hstep, voffB);
            PG8_WAIT_V(6); PG8_BAR; PG8_MMA(1, 1, At, B1); PG8_BAR;
            PG8_LDB(B0, 1, 0); PG8_SCHED; PG8_LDA(At, 1, 0); PG8_STAGE(PG8_SA(0, 1), a2 + hstep, voffA);
            PG8_WAIT_L(8); PG8_BAR; PG8_WAIT_L(0); PG8_MMA(0, 0, At, B0); PG8_BAR; PG8_SCHED;
            PG8_LDB(B1, 1, 1); PG8_STAGE(PG8_SB(1, 0), b3, voffB);
            PG8_BAR; PG8_WAIT_L(0); PG8_MMA(0, 1, At, B1); PG8_BAR;
            PG8_LDA(At, 1, 1); PG8_STAGE(PG8_SA(1, 0), a3, voffA);
            PG8_BAR; PG8_WAIT_L(0); PG8_MMA(1, 0, At, B0); PG8_BAR; PG8_SCHED;
            PG8_STAGE(PG8_SB(1, 1), b3 + hstep, voffB);
            PG8_WAIT_V(6); PG8_BAR; PG8_MMA(1, 1, At, B1); PG8_BAR;
            }
        }
        if constexpr (ALIGN_EPI) { if (wr == 0) PG8_BAR; }
        E(acc, cur, wr, wc, fr, fq);
        if (!has_next) break;
#pragma unroll
        for (int a = 0; a < 2; ++a)
#pragma unroll
            for (int b = 0; b < 2; ++b)
#pragma unroll
                for (int m = 0; m < 4; ++m)
#pragma unroll
                    for (int n = 0; n < 2; ++n) acc[a][b][m][n] = (f32x4){0.f, 0.f, 0.f, 0.f};
        cur = nxt; cA = nA; cB = nB; ++ui;
        if constexpr (ALIGN_EPI) { if (wr == 1) PG8_BAR; }
    }
    PG8_WAIT_V(0);
    if constexpr (!ALIGN_EPI) { if (wr == 0) PG8_BAR; }
    PG8_BAR;
#undef PG8_SA
#undef PG8_SB
#undef PG8_STAGE
#undef PG8_LDA
#undef PG8_LDB
#undef PG8_MMA
#undef PG8_WAIT_V
#undef PG8_WAIT_L
#undef PG8_BAR
#undef PG8_SCHED
}
}

struct Epi1 {
    static constexpr bool PERM = true;
    unsigned char* ws; const float* dt_bias;
    FI void operator()(const f32x4 (&acc)[2][2][4][2], const pg8::Unit& u, int wr, int wc, int fr, int fq) const {
        unsigned char* ws = this->ws; asm volatile("" : "+s"(ws));
        const float* dt_bias = this->dt_bias; asm volatile("" : "+s"(dt_bias));
        const int pn = u.pn;
        int mode, ld, cb; size_t off;
        if (pn < 4) { mode = 0; off = OFF_PV; ld = 1024; cb = pn * 256; }
        else if (pn < 8) { mode = 1; off = OFF_PG; ld = 1024; cb = (pn - 4) * 256; }
        else if (pn < 16) { mode = 1; off = OFF_ZS; ld = 2048; cb = (pn - 8) * 256; }
        else if (pn < 28) { mode = 0; off = OFF_XBC; ld = 3072; cb = (pn - 16) * 256; }
        else if (pn < 32) { mode = 2; off = OFF_Q; ld = 1024; cb = (pn - 28) * 256; }
        else if (pn == 32) { mode = 2; off = OFF_K; ld = 256; cb = 0; }
        else if (pn == 33) { mode = 0; off = OFF_V; ld = 256; cb = 0; }
        else if (pn < 38) { mode = 1; off = OFF_AG; ld = 1024; cb = (pn - 34) * 256; }
        else if (pn < 42) { mode = 3; off = OFF_IQ; ld = 1024; cb = (pn - 38) * 256; }
        else { mode = 4; off = OFF_IK; ld = 64; cb = 0; }
        bf16_t* dst = (bf16_t*)(ws + off);
        const float* cosA = (const float*)(ws + OFF_ROPEA); const float* sinA = cosA + MR * 16;
        const float* cosI = (const float*)(ws + OFF_ROPEI); const float* sinI = cosI + MR * 8;
        float* DT = (float*)(ws + OFF_DT); float* IW = (float*)(ws + OFF_IW);
        const int row0 = u.pm * 256 + wr * 64 + fr;
#pragma unroll
        for (int ai = 0; ai < 2; ++ai)
#pragma unroll
            for (int m = 0; m < 4; ++m) {
                const int row = row0 + ai * 128 + m * 16;
#pragma unroll
                for (int bj = 0; bj < 2; ++bj) {
                    const int cl = bj * 128 + wc * 32 + 8 * fq;
                    float v[8];
#pragma unroll
                    for (int e = 0; e < 4; ++e) { v[e] = acc[ai][bj][m][0][e]; v[4 + e] = acc[ai][bj][m][1][e]; }
                    if (mode == 1) {
#pragma unroll
                        for (int e = 0; e < 8; ++e) v[e] = silu_f(v[e]);
                    } else if (mode == 2) {
                        if (wc == 0) {
                            const f32x4 c0 = *(const f32x4*)(cosA + row * 16 + 8 * (fq & 1)), c1 = *(const f32x4*)(cosA + row * 16 + 8 * (fq & 1) + 4);
                            const f32x4 s0 = *(const f32x4*)(sinA + row * 16 + 8 * (fq & 1)), s1 = *(const f32x4*)(sinA + row * 16 + 8 * (fq & 1) + 4);
#pragma unroll
                            for (int e = 0; e < 8; ++e) { const float o = __shfl_xor(v[e], 32); const float c = e < 4 ? c0[e & 3] : c1[e & 3], s = e < 4 ? s0[e & 3] : s1[e & 3];
                                v[e] = (fq < 2) ? v[e] * c - o * s : v[e] * c + o * s; }
                        }
                    } else if (mode == 3) {
                        if ((wc & 1) == 0) {
                            const f32x4 c0 = *(const f32x4*)(cosI + row * 8), c1 = *(const f32x4*)(cosI + row * 8 + 4);
                            const f32x4 s0 = *(const f32x4*)(sinI + row * 8), s1 = *(const f32x4*)(sinI + row * 8 + 4);
#pragma unroll
                            for (int e = 0; e < 8; ++e) { const float o = __shfl_xor(v[e], 16); const float c = e < 4 ? c0[e & 3] : c1[e & 3], s = e < 4 ? s0[e & 3] : s1[e & 3];
                                const float r = (fq == 0) ? v[e] * c - o * s : v[e] * c + o * s; v[e] = (fq < 2) ? r : v[e]; }
                        }
                    }
                    if (mode != 4) { *(u32x4*)(dst + (size_t)row * ld + cb + cl) = pack8(v); }
                    else if (bj == 0) {
                        if (wc == 0) {
#pragma unroll
                            for (int e = 0; e < 8; ++e) { const float x = v[e] + dt_bias[8 * fq + e]; float ln2c = 0.69314718f; asm volatile("" : "+v"(ln2c));
                                const float sp = x > 20.f ? x : __log2f(1.f + __expf(x)) * ln2c; v[e] = row >= ROW0 ? sp : 0.f; }
                            *(f32x4*)(DT + row * 32 + 8 * fq) = (f32x4){v[0], v[1], v[2], v[3]}; *(f32x4*)(DT + row * 32 + 8 * fq + 4) = (f32x4){v[4], v[5], v[6], v[7]};
                        } else if (wc == 1) {
                            const f32x4 c0 = *(const f32x4*)(cosI + row * 8), c1 = *(const f32x4*)(cosI + row * 8 + 4);
                            const f32x4 s0 = *(const f32x4*)(sinI + row * 8), s1 = *(const f32x4*)(sinI + row * 8 + 4);
#pragma unroll
                            for (int e = 0; e < 8; ++e) { const float o = __shfl_xor(v[e], 16); const float c = e < 4 ? c0[e & 3] : c1[e & 3], s = e < 4 ? s0[e & 3] : s1[e & 3];
                                const float r = (fq == 0) ? v[e] * c - o * s : v[e] * c + o * s; v[e] = (fq < 2) ? r : v[e]; }
                            *(u32x4*)(dst + (size_t)row * 64 + 8 * fq) = pack8(v);
                        } else if (wc == 2) {
                            *(u32x4*)(dst + (size_t)row * 64 + 32 + 8 * fq) = pack8(v);
                        } else if (fq < 2) {
                            const float sc = 0.125f * 0.25f;
                            *(f32x4*)(IW + row * 16 + 8 * fq) = (f32x4){v[0] * sc, v[1] * sc, v[2] * sc, v[3] * sc}; *(f32x4*)(IW + row * 16 + 8 * fq + 4) = (f32x4){v[4] * sc, v[5] * sc, v[6] * sc, v[7] * sc};
                        }
                    }
                }
            }
    }
};
struct EpiOut {
    static constexpr bool PERM = true;
    float* O; int rowoff;
    FI void operator()(const f32x4 (&acc)[2][2][4][2], const pg8::Unit& u, int wr, int wc, int fr, int fq) const {
        float* O = this->O; asm volatile("" : "+s"(O));
        const int row0 = u.pm * 256 + wr * 64 + fr + rowoff;
#pragma unroll
        for (int ai = 0; ai < 2; ++ai)
#pragma unroll
            for (int m = 0; m < 4; ++m)
#pragma unroll
                for (int bj = 0; bj < 2; ++bj) {
                    float* p = O + (size_t)(row0 + ai * 128 + m * 16) * DM + u.pn * 256 + bj * 128 + wc * 32 + 8 * fq;
                    *(f32x4*)p = acc[ai][bj][m][0]; *(f32x4*)(p + 4) = acc[ai][bj][m][1];
                    __builtin_amdgcn_sched_barrier(0);
                }
    }
};
struct EpiPool {
    static constexpr bool PERM = true;
    bf16_t* MIX; const bf16_t* PG; const float* pscale;
    FI void operator()(const f32x4 (&acc)[2][2][4][2], const pg8::Unit& u, int wr, int wc, int fr, int fq) const {
        bf16_t* MIX = this->MIX; asm volatile("" : "+s"(MIX));
        const bf16_t* PG = this->PG; asm volatile("" : "+s"(PG));
        const float* pscale = this->pscale; asm volatile("" : "+s"(pscale));
        const int grp = u.pm / 33, row0 = (u.pm % 33) * 256 + wr * 64 + fr;
#pragma unroll
        for (int ai = 0; ai < 2; ++ai)
#pragma unroll
            for (int m = 0; m < 4; ++m)
#pragma unroll
                for (int bj = 0; bj < 2; ++bj) {
                    const int row = row0 + ai * 128 + m * 16, col = grp * 256 + bj * 128 + wc * 32 + 8 * fq;
                    float g[8]; unpack8(*(const u32x4*)(PG + (size_t)row * 1024 + col), g);
                    const f32x4 p0 = *(const f32x4*)(pscale + col), p1 = *(const f32x4*)(pscale + col + 4);
                    float v[8];
#pragma unroll
                    for (int e = 0; e < 4; ++e) { v[e] = acc[ai][bj][m][0][e] * p0[e] * g[e]; v[4 + e] = acc[ai][bj][m][1][e] * p1[e] * g[4 + e]; }
                    *(u32x4*)(MIX + (size_t)row * DMIX + col) = pack8(v);
                    __builtin_amdgcn_sched_barrier(0);
                }
    }
};

FI int src_col_win(int np) {
    if (np < 7168) return np;
    if (np < 10752) return np + 32;
    if (np < 10784) return 7168 + (np - 10752);
    if (np < 10864) return np;
    return -1;
}
template <bool MAP>
FI void transpose_item(const float* W, int K, int N, bf16_t* WT, float* scr, int item, int nblk, int lane) {
    const int kb = item / nblk, nb = item % nblk, k0 = 64 * kb, n0 = 32 * nb;
    int sc = n0 + (lane & 31); if (MAP) sc = src_col_win(sc);
    float tv[32];
#pragma unroll
    for (int i = 0; i < 32; ++i) { const int kk = 2 * i + (lane >> 5); tv[i] = sc >= 0 ? __builtin_nontemporal_load(&W[(size_t)(k0 + kk) * N + sc]) : 0.f; }
#pragma unroll
    for (int i = 0; i < 32; ++i) { const int kk = 2 * i + (lane >> 5); scr[kk * 33 + (lane & 31)] = tv[i]; }
    asm volatile("s_waitcnt lgkmcnt(0)" ::: "memory");
    const int c = lane & 7;
#pragma unroll
    for (int j = 0; j < 4; ++j) { const int n = (lane >> 3) + 8 * j; const float* s = scr + (8 * c) * 33 + n;
        u32x4 o; o.x = cvt_pk_bf16(s[0 * 33], s[1 * 33]); o.y = cvt_pk_bf16(s[2 * 33], s[3 * 33]); o.z = cvt_pk_bf16(s[4 * 33], s[5 * 33]); o.w = cvt_pk_bf16(s[6 * 33], s[7 * 33]);
        *(u32x4*)(WT + (size_t)(n0 + n) * K + k0 + 8 * c) = o; }
    asm volatile("s_waitcnt lgkmcnt(0)" ::: "memory");
}
FI void convert_weights(const Args& a, int layer, unsigned char* lds) {
    const int tid = tid_l(), lane = tid & 63, w = tid >> 6;
    float* scr = (float*)(lds + w * 16384);
    const int gw = blockIdx.x * 8 + w, NGW = gridDim.x * 8;
    constexpr int I_IN = (DM / 64) * (NP / 32), I_OUT = (DMIX / 64) * (DM / 32);
    const float* win = a.in[4] + (size_t)layer * DM * 10864; const float* wout = a.in[13] + (size_t)layer * DMIX * DM;
    bf16_t* WIN = (bf16_t*)(a.ws + OFF_WIN); bf16_t* WOUT = (bf16_t*)(a.ws + OFF_WOUT);
#pragma unroll 1
    for (int it = gw; it < I_IN + I_OUT; it += NGW) {
        if (it < I_IN) transpose_item<true>(win, DM, 10864, WIN, scr, it, NP / 32, lane);
        else transpose_item<false>(wout, DMIX, DM, WOUT, scr, it - I_IN, DM / 32, lane);
    }
}
FI void convert_pool_w(const Args& a, unsigned char* lds) {
    const int tid = tid_l(), lane = tid & 63, w = tid >> 6;
    float* scr = (float*)(lds + w * 16384);
    const int gw = blockIdx.x * 8 + w, NGW = gridDim.x * 8;
    bf16_t* PWT = (bf16_t*)(a.ws + OFF_PWT);
#pragma unroll 1
    for (int it = gw; it < 8 * 32; it += NGW) { const int mat = it >> 5;
        transpose_item<false>(a.in[5] + (size_t)mat * 65536, 256, 256, PWT + (size_t)mat * 65536, scr, it & 31, 8, lane); }
}
FI void rope_tables(const Args& a) {
    float* cosA = (float*)(a.ws + OFF_ROPEA); float* sinA = cosA + MR * 16;
    float* cosI = (float*)(a.ws + OFF_ROPEI); float* sinI = cosI + MR * 8;
    const int gt = blockIdx.x * 512 + tid_l(), NT = gridDim.x * 512;
#pragma unroll 1
    for (int i = gt; i < MR * 24; i += NT) {
        const int row = i / 24, j = i % 24; const int pos = row >= ROW0 ? row - ROW0 : 0;
        const float ex = j < 16 ? -(float)j * (2.0f / 32.0f) : -(float)(j - 16) * (2.0f / 16.0f);
        const float inv = exp2f(ex * 18.931568569324174f);
        const float ang = (float)pos * inv;
        double rev = (double)ang * 0.15915494309189535; rev -= rint(rev);
        const float rf = (float)rev;
        const float cs = __builtin_amdgcn_cosf(rf), sn = __builtin_amdgcn_sinf(rf);
        if (j < 16) { cosA[row * 16 + j] = cs; sinA[row * 16 + j] = sn; } else { cosI[row * 8 + j - 16] = cs; sinI[row * 8 + j - 16] = sn; }
    }
}
FI void row_pass(const Args& a, int mode, int layer) {
    const int tid = tid_l(), lane = tid & 63, w = tid >> 6;
    const int gw = blockIdx.x * 8 + w, NGW = gridDim.x * 8;
    float* H = (float*)(a.ws + OFF_H); bf16_t* U = (bf16_t*)(a.ws + OFF_U); const float* OUT = (const float*)(a.ws + OFF_OUT);
    const float* postw = a.in[3] + (size_t)layer * DM;
    const float* prew = a.in[2] + (size_t)(mode == 0 ? 0 : layer + 1) * DM;
#pragma unroll 1
    for (int row = gw; row < MR; row += NGW) {
        if (row < ROW0) {
            if (mode != 2) {
#pragma unroll
                for (int j = 0; j < 8; ++j) { if (mode == 0) *(f32x4*)(H + (size_t)row * DM + 4 * lane + 256 * j) = (f32x4){0.f, 0.f, 0.f, 0.f};
                    *(u32x2*)(U + (size_t)row * DM + 4 * lane + 256 * j) = (u32x2){0u, 0u}; }
            }
            continue;
        }
        if (mode == 2 && row < 256) continue;
        f32x4 h[8];
        if (mode == 0) {
            const float* src = row < 256 ? a.in[1] + (size_t)(row - ROW0) * DM : a.in[0] + (size_t)(row - 256) * DM;
#pragma unroll
            for (int j = 0; j < 8; ++j) h[j] = *(const f32x4*)(src + 4 * lane + 256 * j);
        } else {
            f32x4 o[8]; float ss = 0.f;
#pragma unroll
            for (int j = 0; j < 8; ++j) { o[j] = *(const f32x4*)(OUT + (size_t)row * DM + 4 * lane + 256 * j); ss += o[j].x * o[j].x + o[j].y * o[j].y + o[j].z * o[j].z + o[j].w * o[j].w; }
            const float rstd = rsqrtf(wave_sum(ss) * (1.f / DM) + EPS);
#pragma unroll
            for (int j = 0; j < 8; ++j) { const f32x4 pw = *(const f32x4*)(postw + 4 * lane + 256 * j); h[j] = *(const f32x4*)(H + (size_t)row * DM + 4 * lane + 256 * j) + o[j] * rstd * pw; }
        }
        if (mode == 2) {
#pragma unroll
            for (int j = 0; j < 8; ++j) *(f32x4*)(a.out + (size_t)(row - 256) * DM + 4 * lane + 256 * j) = h[j];
            continue;
        }
        float ss = 0.f;
#pragma unroll
        for (int j = 0; j < 8; ++j) { *(f32x4*)(H + (size_t)row * DM + 4 * lane + 256 * j) = h[j]; ss += h[j].x * h[j].x + h[j].y * h[j].y + h[j].z * h[j].z + h[j].w * h[j].w; }
        const float rstd = rsqrtf(wave_sum(ss) * (1.f / DM) + EPS);
#pragma unroll
        for (int j = 0; j < 8; ++j) { const f32x4 pw = *(const f32x4*)(prew + 4 * lane + 256 * j); const f32x4 u = h[j] * rstd * pw;
            *(u32x2*)(U + (size_t)row * DM + 4 * lane + 256 * j) = (u32x2){cvt_pk_bf16(u.x, u.y), cvt_pk_bf16(u.z, u.w)}; }
    }
}

FI void conv8(const bf16_t* XBC, const float* cw, const float* cbias, int R, int col, float* o) {
    if (R < ROW0) {
#pragma unroll
        for (int e = 0; e < 8; ++e) o[e] = 0.f;
        return;
    }
    const f32x4 b0 = *(const f32x4*)(cbias + col), b1 = *(const f32x4*)(cbias + col + 4);
#pragma unroll
    for (int e = 0; e < 4; ++e) { o[e] = b0[e]; o[4 + e] = b1[e]; }
#pragma unroll
    for (int i = 0; i < 4; ++i) {
        float x[8]; unpack8(*(const u32x4*)(XBC + (size_t)(R - 3 + i) * 3072 + col), x);
        const f32x4 w0 = *(const f32x4*)(cw + i * 3072 + col), w1 = *(const f32x4*)(cw + i * 3072 + col + 4);
#pragma unroll
        for (int e = 0; e < 4; ++e) { o[e] += x[e] * w0[e]; o[4 + e] += x[4 + e] * w1[e]; }
    }
#pragma unroll
    for (int e = 0; e < 8; ++e) o[e] = silu_f(o[e]);
}
constexpr int LDP = 136;
FI bf16x8 ldsfrag(const bf16_t* base, int row0, int kk, int lane) { return *(const bf16x8*)(base + (row0 + (lane & 31)) * LDP + kk * 16 + 8 * (lane >> 5)); }

FI void ssd_s1(const Args& a, int layer, int c, int g, unsigned char* lds) {
    const int tid = tid_l(), lane = tid & 63, w = tid >> 6;
    const int r0 = 128 + 128 * c;
    bf16_t* cmS = (bf16_t*)lds; bf16_t* bmS = cmS + 128 * LDP; bf16_t* bmT = bmS + 128 * LDP;
    bf16_t* G = cmS; bf16_t* xdtT = bmS; bf16_t* xdtdT = bmS + 64 * LDP;
    float* csS = (float*)(lds + 104448); float* dtS = csS + 1024;
    const bf16_t* XBC = (const bf16_t*)(a.ws + OFF_XBC);
    const float* cw = a.in[7] + (size_t)layer * 4 * 3072; const float* cbias = a.in[8] + (size_t)layer * 3072;
    const float* DT = (const float*)(a.ws + OFF_DT);
    bf16_t* CM = (bf16_t*)(a.ws + OFF_CM); bf16_t* XS = (bf16_t*)(a.ws + OFF_XS);
    float* CSB = (float*)(a.ws + OFF_CSB); bf16_t* YD = (bf16_t*)(a.ws + OFF_YD); float* ST = (float*)(a.ws + OFF_ST); float* CD = (float*)(a.ws + OFF_CD);
#pragma unroll 4
    for (int it = tid; it < 4096; it += 512) {
        const int mat = it >> 11, row = (it >> 4) & 127, cg8 = it & 15;
        const int col = 2048 + mat * 512 + g * 128 + cg8 * 8, R = r0 + row;
        float o[8]; conv8(XBC, cw, cbias, R, col, o);
        const u32x4 pk = pack8(o);
        if (mat == 0) {
            *(u32x4*)(bmS + row * LDP + cg8 * 8) = pk;
#pragma unroll
            for (int e = 0; e < 8; ++e) bmT[(cg8 * 8 + e) * LDP + row] = f2bf(o[e]);
        } else {
            *(u32x4*)(cmS + row * LDP + cg8 * 8) = pk;
            *(u32x4*)(CM + (size_t)R * 512 + g * 128 + cg8 * 8) = pk;
        }
    }
    __syncthreads();
    f32x16 cb[2];
#pragma unroll
    for (int i = 0; i < 16; ++i) { cb[0][i] = 0.f; cb[1][i] = 0.f; }
    const int m0 = 32 * (w >> 1);
    {
        const int n0 = 64 * (w & 1);
#pragma unroll
        for (int kk = 0; kk < 8; ++kk) { const bf16x8 av = ldsfrag(cmS, m0, kk, lane);
            cb[0] = mfma32(av, ldsfrag(bmS, n0, kk, lane), cb[0]); cb[1] = mfma32(av, ldsfrag(bmS, n0 + 32, kk, lane), cb[1]); }
    }
    {
        const int h = 8 * g + w; const float ah = -__expf(a.in[10][layer * 32 + h]);
        const float d0 = DT[(r0 + 2 * lane) * 32 + h], d1 = DT[(r0 + 2 * lane + 1) * 32 + h];
        const float a0 = d0 * ah, a1 = d1 * ah; float s = a0 + a1;
#pragma unroll
        for (int o = 1; o < 64; o <<= 1) { const float t = __shfl_up(s, o); if (lane >= o) s += t; }
        csS[w * 128 + 2 * lane] = s - a1; csS[w * 128 + 2 * lane + 1] = s; dtS[w * 128 + 2 * lane] = d0; dtS[w * 128 + 2 * lane + 1] = d1;
        CSB[(r0 + 2 * lane) * 32 + h] = s - a1; CSB[(r0 + 2 * lane + 1) * 32 + h] = s;
        if (lane == 63) CD[c * 32 + h] = __expf(s);
    }
    __syncthreads();
#pragma unroll 1
    for (int r = 0; r < 8; ++r) {
        const int h = 8 * g + r;
        {
            int ln = lane; asm volatile("" : "+v"(ln));
            const int n0 = 64 * (w & 1);
#pragma unroll
            for (int t = 0; t < 2; ++t)
#pragma unroll
                for (int i = 0; i < 16; ++i) { const int l = m0 + (i & 3) + 8 * (i >> 2) + 4 * (ln >> 5), s = n0 + 32 * t + (ln & 31);
                    const int msk = (s - l - 1) >> 31;
                    const float v = __uint_as_float(__float_as_uint(cb[t][i] * __expf(fminf(csS[r * 128 + l] - csS[r * 128 + s], 0.f))) & (unsigned)msk);
                    G[l * LDP + s] = f2bf(v); if ((i & 3) == 3) __builtin_amdgcn_sched_barrier(0); }
        }
#pragma unroll 2
        for (int it = tid; it < 1024; it += 512) {
            const int row = it >> 3, pg = it & 7, R = r0 + row, col = h * 64 + pg * 8;
            float o[8]; conv8(XBC, cw, cbias, R, col, o);
            __builtin_nontemporal_store(pack8(o), (u32x4*)(XS + (size_t)R * 2048 + col));
            const float dtv = dtS[r * 128 + row], dec = __expf(csS[r * 128 + 127] - csS[r * 128 + row]);
#pragma unroll
            for (int e = 0; e < 8; ++e) { const float xd = o[e] * dtv; xdtT[(pg * 8 + e) * LDP + row] = f2bf(xd); xdtdT[(pg * 8 + e) * LDP + row] = f2bf(xd * dec); }
        }
        __syncthreads();
        {
            const int n0 = 32 * (w & 1); f32x16 acc;
#pragma unroll
            for (int i = 0; i < 16; ++i) acc[i] = 0.f;
#pragma unroll
            for (int kk = 0; kk < 8; ++kk) acc = mfma32(ldsfrag(G, m0, kk, lane), ldsfrag(xdtT, n0, kk, lane), acc);
#pragma unroll
            for (int i = 0; i < 16; ++i) { const int l = m0 + (i & 3) + 8 * (i >> 2) + 4 * (lane >> 5); __builtin_nontemporal_store(f2bf(acc[i]), &YD[(size_t)(r0 + l) * 2048 + h * 64 + n0 + (lane & 31)]); }
        }
        {
            const int p0 = 32 * (w >> 2), n0 = 32 * (w & 3); f32x16 acc;
#pragma unroll
            for (int i = 0; i < 16; ++i) acc[i] = 0.f;
#pragma unroll
            for (int kk = 0; kk < 8; ++kk) acc = mfma32(ldsfrag(xdtdT, p0, kk, lane), ldsfrag(bmT, n0, kk, lane), acc);
#pragma unroll
            for (int i = 0; i < 16; ++i) { const int pp = p0 + (i & 3) + 8 * (i >> 2) + 4 * (lane >> 5); __builtin_nontemporal_store(acc[i], &ST[((size_t)(c * 32 + h) * 64 + pp) * 128 + n0 + (lane & 31)]); }
        }
        __syncthreads();
    }
}

FI void ssd_scan_item(const Args& a, int item) {
    const int q = item * 512 + tid_l();
    const int h = q >> 11;
    const f32x4* base = (const f32x4*)(a.ws + OFF_ST) + q; const float* CD = (const float*)(a.ws + OFF_CD);
    u32x2* hs = (u32x2*)(a.ws + OFF_HS) + q;
    f32x4 state = (f32x4){0.f, 0.f, 0.f, 0.f};
#pragma unroll 1
    for (int c0 = 0; c0 < NCH; c0 += 13) {
        f32x4 v[13]; float cd[13];
#pragma unroll
        for (int j = 0; j < 13; ++j) { v[j] = __builtin_nontemporal_load(&base[(size_t)(c0 + j) * 65536]); cd[j] = CD[(c0 + j) * 32 + h]; }
#pragma unroll
        for (int j = 0; j < 13; ++j) { hs[(size_t)(c0 + j) * 65536] = (u32x2){cvt_pk_bf16(state.x, state.y), cvt_pk_bf16(state.z, state.w)}; state = state * cd[j] + v[j]; }
    }
}

FI void ssd_s3(const Args& a, int layer, int c, int g, unsigned char* lds) {
    const int tid = tid_l(), lane = tid & 63, w = tid >> 6;
    const int r0 = 128 + 128 * c;
    bf16_t* cmS = (bf16_t*)lds; bf16_t* Hs = cmS + 128 * LDP; float* rowss = (float*)(lds + 53248);
    const bf16_t* CM = (const bf16_t*)(a.ws + OFF_CM); const bf16_t* XS = (const bf16_t*)(a.ws + OFF_XS); const bf16_t* ZS = (const bf16_t*)(a.ws + OFF_ZS);
    const float* CSB = (const float*)(a.ws + OFF_CSB); const bf16_t* YD = (const bf16_t*)(a.ws + OFF_YD); const float* ST = (const float*)(a.ws + OFF_ST);
    bf16_t* MIX = (bf16_t*)(a.ws + OFF_MIX);
    const float* dskip = a.in[11] + layer * 32; const float* normw = a.in[12] + (size_t)layer * 2048;
    {
        u32x4 t[4];
#pragma unroll
        for (int j = 0; j < 4; ++j) { const int it = tid + 512 * j, row = it >> 4, cg8 = it & 15; t[j] = *(const u32x4*)(CM + (size_t)(r0 + row) * 512 + g * 128 + cg8 * 8); }
#pragma unroll
        for (int j = 0; j < 4; ++j) { const int it = tid + 512 * j, row = it >> 4, cg8 = it & 15; *(u32x4*)(cmS + row * LDP + cg8 * 8) = t[j]; }
    }
    if (tid < 128) rowss[tid] = 0.f;
    const int pt = w & 1, lt = w >> 1;
    const int l = lt * 32 + (lane & 31), R = r0 + l;
    const bf16_t* HSB = (const bf16_t*)(a.ws + OFF_HS);
    u32x4 hreg[2];
    {
        const bf16_t* src = HSB + ((size_t)(c * 32 + 8 * g) * 64) * 128;
#pragma unroll
        for (int j = 0; j < 2; ++j) { const int it = tid + 512 * j; hreg[j] = *(const u32x4*)(src + (size_t)(it >> 4) * 128 + (it & 15) * 8); }
    }
    float ss = 0.f;
#pragma unroll 1
    for (int r = 0; r < 8; ++r) {
        const int h = 8 * g + r;
        __syncthreads();
#pragma unroll
        for (int j = 0; j < 2; ++j) { const int it = tid + 512 * j; *(u32x4*)(Hs + (it >> 4) * LDP + (it & 15) * 8) = hreg[j]; }
        __syncthreads();
        if (r < 7) {
            const bf16_t* src = HSB + ((size_t)(c * 32 + h + 1) * 64) * 128;
#pragma unroll
            for (int j = 0; j < 2; ++j) { const int it = tid + 512 * j; hreg[j] = *(const u32x4*)(src + (size_t)(it >> 4) * 128 + (it & 15) * 8); }
        }
        const int colb = h * 64 + pt * 32 + 4 * (lane >> 5);
        f32x4 yd[4]; u32x2 xs[4], zs[4];
#pragma unroll
        for (int q = 0; q < 4; ++q) { const size_t o = (size_t)R * 2048 + colb + 8 * q; { const u32x2 yr = *(const u32x2*)(YD + o); yd[q] = (f32x4){bflo(yr.x), bfhi(yr.x), bflo(yr.y), bfhi(yr.y)}; } xs[q] = *(const u32x2*)(XS + o); zs[q] = *(const u32x2*)(ZS + o); }
        const float ecs = __expf(CSB[R * 32 + h]), dsk = dskip[h];
        f32x16 acc;
#pragma unroll
        for (int i = 0; i < 16; ++i) acc[i] = 0.f;
#pragma unroll
        for (int kk = 0; kk < 8; ++kk) acc = mfma32(ldsfrag(Hs, pt * 32, kk, lane), ldsfrag(cmS, lt * 32, kk, lane), acc);
#pragma unroll
        for (int q = 0; q < 4; ++q) {
            const float y0 = (yd[q].x + acc[4 * q] * ecs + dsk * bflo(xs[q].x)) * bflo(zs[q].x);
            const float y1 = (yd[q].y + acc[4 * q + 1] * ecs + dsk * bfhi(xs[q].x)) * bfhi(zs[q].x);
            const float y2 = (yd[q].z + acc[4 * q + 2] * ecs + dsk * bflo(xs[q].y)) * bflo(zs[q].y);
            const float y3 = (yd[q].w + acc[4 * q + 3] * ecs + dsk * bfhi(xs[q].y)) * bfhi(zs[q].y);
            const unsigned w0 = cvt_pk_bf16(y0, y1), w1 = cvt_pk_bf16(y2, y3);
            const float b0 = bflo(w0), b1 = bfhi(w0), b2 = bflo(w1), b3 = bfhi(w1);
            ss += b0 * b0 + b1 * b1 + b2 * b2 + b3 * b3;
            *(u32x2*)(MIX + (size_t)R * DMIX + 1024 + colb + 8 * q) = (u32x2){w0, w1};
        }
    }
    ss += __shfl_xor(ss, 32);
    if (lane < 32) atomicAdd(&rowss[l], ss);
    __threadfence();
    __syncthreads();
#pragma unroll 1
    for (int l2 = w * 16; l2 < w * 16 + 16; l2 += 4) {
        u32x4 t[4];
#pragma unroll
        for (int j = 0; j < 4; ++j) t[j] = *(const u32x4*)(MIX + (size_t)(r0 + l2 + j) * DMIX + 1024 + g * 512 + lane * 8);
        const f32x4 n0v = *(const f32x4*)(normw + g * 512 + lane * 8), n1v = *(const f32x4*)(normw + g * 512 + lane * 8 + 4);
#pragma unroll
        for (int j = 0; j < 4; ++j) {
            float v[8]; unpack8(t[j], v);
            const float rstd = rsqrtf(rowss[l2 + j] * (1.f / 512.f) + EPS);
#pragma unroll
            for (int e = 0; e < 4; ++e) { v[e] *= rstd * n0v[e]; v[4 + e] *= rstd * n1v[e]; }
            *(u32x4*)(MIX + (size_t)(r0 + l2 + j) * DMIX + 1024 + g * 512 + lane * 8) = pack8(v);
        }
    }
}

FI void pool_pre_item(const Args& a, int item) {
    const bf16_t* PV = (const bf16_t*)(a.ws + OFF_PV); bf16_t* PA = (bf16_t*)(a.ws + OFF_U);
    const int q = tid_l();
    const int col = (q & 127) * 8, grp = col >> 8, r0 = item * 32 + (q >> 7) * 8, wdw = 2 << grp;
    u32x4 raw[23];
#pragma unroll
    for (int j = 0; j < 23; ++j) { const int rr = r0 - 15 + j; raw[j] = *(const u32x4*)(PV + (size_t)(rr < 0 ? 0 : rr) * 1024 + col); }
#pragma unroll
    for (int i = 0; i < 8; ++i) {
        const int row = r0 + i, t = row - ROW0;
        float y[8];
#pragma unroll
        for (int e = 0; e < 8; ++e) y[e] = 0.f;
        if (t >= 0) {
            float v0[8]; unpack8(raw[15 + i], v0);
            float sacc[8];
#pragma unroll
            for (int e = 0; e < 8; ++e) sacc[e] = v0[e];
#pragma unroll
            for (int j = 1; j < 16; ++j) { float x[8]; unpack8(raw[15 + i - j], x); const float m = j < wdw ? 1.f : 0.f;
#pragma unroll
                for (int e = 0; e < 8; ++e) sacc[e] += m * x[e]; }
            const float ic = 1.f / (float)min(wdw, t + 1);
#pragma unroll
            for (int e = 0; e < 8; ++e) y[e] = sacc[e] * ic - v0[e];
        }
        *(u32x4*)(PA + ((size_t)grp * MR + row) * 256 + (col & 255)) = pack8(y);
    }
}

constexpr int IDX_BLOCK_TASKS = 1188;
template <int MODE>
FI void indexer_block_task(const Args& a, int id, unsigned char* lds) {
    const int tid = tid_l(), lane = tid & 63, w = tid >> 6;
    int m = 65, rem = id;
    for (;;) { const int c = 4 * ((m + 7) >> 3); if (rem < c) break; rem -= c; --m; }
    const int per = (m + 7) >> 3, r = rem / per, j = rem - r * per;
    const int qg = 4 * m + r, qrow0 = 32 * qg, qb = qrow0 >> 8;
    const bf16_t* IQ = (const bf16_t*)(a.ws + OFF_IQ); const bf16_t* IK = (const bf16_t*)(a.ws + OFF_IK); const float* IW = (const float*)(a.ws + OFF_IW);
    LAS bf16_t* qs = (LAS bf16_t*)((LAS unsigned char*)lds);
    {
        const int row = tid >> 4, c = tid & 15;
        const bf16_t* src = IQ + (size_t)(qrow0 + row) * 1024 + c * 64;
        u32x4 t[8];
#pragma unroll
        for (int e = 0; e < 8; ++e) t[e] = *(const u32x4*)(src + 8 * e);
#pragma unroll
        for (int e = 0; e < 8; ++e) *(LAS u32x4*)(qs + row * 1032 + c * 64 + 8 * e) = t[e];
    }
    const int kt = 8 * j + 1 + w;
    bf16x8 ka[4][4];
    if (kt <= m) {
#pragma unroll
        for (int mt = 0; mt < 4; ++mt)
#pragma unroll
            for (int kk = 0; kk < 4; ++kk) ka[mt][kk] = *(const bf16x8*)(IK + (size_t)(128 * kt + 32 * mt + (lane & 31)) * 64 + kk * 16 + 8 * (lane >> 5));
    }
    __syncthreads();
    if (kt > m) return;
    f32x16 acc[4];
#pragma unroll
    for (int mt = 0; mt < 4; ++mt)
#pragma unroll
        for (int i = 0; i < 16; ++i) acc[mt][i] = 0.f;
    const float* wp = IW + (size_t)(qrow0 + (lane & 31)) * 16;
    const LAS bf16_t* qfr = qs + (lane & 31) * 1032 + 8 * (lane >> 5);
#define IDX_CHAIN(dst, mt, qq) do { _Pragma("unroll") for (int i = 0; i < 16; ++i) dst[i] = 0.f; _Pragma("unroll") for (int kk = 0; kk < 4; ++kk) dst = mfma32(ka[mt][kk], qq[kk], dst); } while (0)
#define IDX_ACC(src, mt, wv) do { } while (0)
#define IDX_STEP(dstC, mtC, qq, srcA, mtA, wv) do { _Pragma("unroll") for (int kk = 0; kk < 4; ++kk) { \
        if (kk == 0) { _Pragma("unroll") for (int i = 0; i < 16; ++i) dstC[i] = 0.f; } \
        dstC = mfma32(ka[mtC][kk], qq[kk], dstC); __builtin_amdgcn_sched_barrier(0); \
        _Pragma("unroll") for (int i = 0; i < 4; ++i) acc[mtA][4 * kk + i] += wv * __int_as_float(max(__float_as_int(srcA[4 * kk + i]), 0)); \
        __builtin_amdgcn_sched_barrier(0); } } while (0)
    bf16x8 qv[4], qx[4]; f32x16 sA, sB;
    float wh = wp[0];
#pragma unroll
    for (int kk = 0; kk < 4; ++kk) qv[kk] = *(const LAS bf16x8*)(qfr + kk * 16);
    IDX_CHAIN(sA, 0, qv);
#pragma unroll 1
    for (int h = 0; h < 16; ++h) {
        const int hn = h < 15 ? h + 1 : 15;
        const float wnx = wp[hn];
#pragma unroll
        for (int kk = 0; kk < 4; ++kk) qx[kk] = *(const LAS bf16x8*)(qfr + hn * 64 + kk * 16);
        IDX_STEP(sB, 1, qv, sA, 0, wh);
        IDX_STEP(sA, 2, qv, sB, 1, wh);
        IDX_STEP(sB, 3, qv, sA, 2, wh);
        IDX_STEP(sA, 0, qx, sB, 3, wh);
#pragma unroll
        for (int kk = 0; kk < 4; ++kk) qv[kk] = qx[kk];
        wh = wnx;
    }
#undef IDX_STEP
#undef IDX_CHAIN
#undef IDX_ACC
    int ln2 = lane; asm volatile("" : "+v"(ln2));
    float* dst = (float*)(a.ws + OFF_SC) + (size_t)(qb * qb + kt - 1) * 32768 + (size_t)((qrow0 & 255) + (ln2 & 31)) * 128 + 4 * (ln2 >> 5);
#pragma unroll
    for (int mt = 0; mt < 4; ++mt)
#pragma unroll
        for (int i4 = 0; i4 < 4; ++i4) { if (MODE == 0 || acc[mt][4 * i4] == 12345.678f) __builtin_nontemporal_store((f32x4){acc[mt][4 * i4], acc[mt][4 * i4 + 1], acc[mt][4 * i4 + 2], acc[mt][4 * i4 + 3]}, (f32x4*)(dst + 32 * mt + 8 * i4)); }
}

template <int N, int STRIDE>
FI unsigned bisect_keys(const unsigned (&key)[N], int target, bool& exact) {
    unsigned prefix = 0u; exact = false;
#pragma unroll 1
    for (int bit = 31; bit >= 0; --bit) {
        const unsigned cand = prefix | (1u << bit);
        int cnt = 0;
#pragma unroll
        for (int i = 0; i < N; i += STRIDE) { cnt += __popcll(__ballot(key[i] >= cand)); if (((i / STRIDE) & 7) == 7) __builtin_amdgcn_sched_barrier(0); }
        if (cnt >= target) { prefix = cand; if (cnt == target) { exact = true; break; } }
    }
    return prefix;
}
template <int NJ>
FI void topk_row(const Args& a, int rq, int lane, unsigned* cand_k, int* cand_i) {
    const int qb = rq >> 8;
    const float* SC = (const float*)(a.ws + OFF_SC);
    int* IDX = (int*)(a.ws + OFF_IDX) + (size_t)rq * 256; int* CNT = (int*)(a.ws + OFF_CNT);
    unsigned key[NJ * 4];
    {
        const float* rowp = SC + (size_t)(qb * qb) * 32768 + (size_t)(rq & 255) * 128 + 4 * (lane & 31) + (size_t)(lane >> 5) * 32768;
        const int ktmax = 2 * qb + 1 - (lane >> 5);
#pragma unroll
        for (int j = 0; j < NJ; ++j) {
            const int jj = (1 + 2 * j <= ktmax) ? j : 0;
            const u32x4 v = __builtin_nontemporal_load((const u32x4*)(rowp + (size_t)jj * 65536));
            key[4 * j] = v.x; key[4 * j + 1] = v.y; key[4 * j + 2] = v.z; key[4 * j + 3] = v.w;
        }
        __builtin_amdgcn_sched_barrier(0);
#pragma unroll
        for (int j = 0; j < NJ; ++j) {
            const int k0 = 128 * (1 + 2 * j + (lane >> 5)) + 4 * (lane & 31);
#pragma unroll
            for (int e = 0; e < 4; ++e) { const unsigned u = key[4 * j + e]; const unsigned m = (u & 0x80000000u) ? ~u : (u | 0x80000000u);
                const int kr = k0 + e; key[4 * j + e] = (kr >= ROW0 && kr <= rq) ? m : 0u; }
            if ((j & 3) == 3) __builtin_amdgcn_sched_barrier(0);
        }
    }
    const int n = rq - ROW0 + 1, want = n < 256 ? n : 256;
    int ln2 = lane; asm volatile("" : "+v"(ln2));
    const unsigned long long ltmask = (1ull << ln2) - 1ull;
    const int kbase = 128 * (1 + (ln2 >> 5)) + 4 * (ln2 & 31);
    bool done = false;
    if (n > 256) {
        bool ex; unsigned Ts = bisect_keys<NJ * 4, 8>(key, 48, ex);
        if (Ts == 0u) Ts = 1u;
        Ts = (unsigned)__builtin_amdgcn_readfirstlane((int)Ts);
        int c = 0;
#pragma unroll
        for (int i = 0; i < NJ * 4; ++i) { c += __popcll(__ballot(key[i] >= Ts)); if ((i & 7) == 7) __builtin_amdgcn_sched_barrier(0); }
        if (c >= 256 && c <= 512) {
            asm volatile("" : "+s"(Ts));
            int base = 0;
#pragma unroll
            for (int i = 0; i < NJ * 4; ++i) {
                const bool pr = key[i] >= Ts; const unsigned long long mk = __ballot(pr);
                if (pr) { const int pos = base + __popcll(mk & ltmask); cand_k[pos] = key[i]; cand_i[pos] = kbase + 256 * (i >> 2) + (i & 3); }
                base += __popcll(mk);
                if ((i & 3) == 3) __builtin_amdgcn_sched_barrier(0);
            }
            asm volatile("s_waitcnt lgkmcnt(0)" ::: "memory");
            unsigned ck[8]; int ci[8];
#pragma unroll
            for (int r = 0; r < 8; ++r) { const int p = ln2 + 64 * r; ck[r] = p < c ? cand_k[p] : 0u; ci[r] = p < c ? cand_i[p] : 0; }
            bool exact; const unsigned pre = bisect_keys<8, 1>(ck, 256, exact);
            const unsigned P = exact ? pre - 1u : pre;
            int ob = 0;
#pragma unroll
            for (int r = 0; r < 8; ++r) { const bool pr = ck[r] > P; const unsigned long long mk = __ballot(pr);
                if (pr) IDX[ob + __popcll(mk & ltmask)] = ci[r];
                ob += __popcll(mk); }
            if (ob < 256) {
#pragma unroll
                for (int r = 0; r < 8; ++r) { const bool pr = ck[r] == P; const unsigned long long mk = __ballot(pr);
                    const int pos = ob + __popcll(mk & ltmask);
                    if (pr && pos < 256) IDX[pos] = ci[r];
                    ob += __popcll(mk); }
            }
            done = true;
        }
    }
    if (!done) {
        unsigned P = 0u;
        if (n > 256) { bool exact; const unsigned pre = bisect_keys<NJ * 4, 1>(key, 256, exact); P = exact ? pre - 1u : pre; }
        int base = 0;
#pragma unroll
        for (int i = 0; i < NJ * 4; ++i) {
            const bool pr = key[i] > P; const unsigned long long mk = __ballot(pr);
            if (pr) IDX[base + __popcll(mk & ltmask)] = kbase + 256 * (i >> 2) + (i & 3);
            base += __popcll(mk);
            if ((i & 3) == 3) __builtin_amdgcn_sched_barrier(0);
        }
        if (base < want) {
#pragma unroll
            for (int i = 0; i < NJ * 4; ++i) {
                const bool pr = key[i] == P; const unsigned long long mk = __ballot(pr);
                const int pos = base + __popcll(mk & ltmask);
                if (pr && pos < want) IDX[pos] = kbase + 256 * (i >> 2) + (i & 3);
                base += __popcll(mk);
                if ((i & 3) == 3) __builtin_amdgcn_sched_barrier(0);
            }
        }
    }
    if (lane == 0) CNT[rq] = want;
}
FI void topk_item(const Args& a, int item, unsigned char* lds) {
    const int tid = tid_l(), lane = tid & 63, w = tid >> 6;
    const int rq = MR - 1 - item;
    if (rq < ROW0) return;
    unsigned* ck = (unsigned*)(lds + w * 4096); int* ci = (int*)(lds + w * 4096 + 2048);
    const int qb = rq >> 8;
    if (qb < 8) topk_row<8>(a, rq, lane, ck, ci);
    else if (qb < 16) topk_row<16>(a, rq, lane, ck, ci);
    else if (qb < 24) topk_row<24>(a, rq, lane, ck, ci);
    else topk_row<33>(a, rq, lane, ck, ci);
}

template <int ATTV>
FI void attn_item(const Args& a, int item, unsigned char* lds) {
    const int tid = tid_l(), lane = tid & 63, w = tid >> 6;
    const int rq = ROW0 + (item >> 1), g = item & 1;
    LAS unsigned char* sl = (LAS unsigned char*)lds + w * 16384;
    LAS float* Pw = (LAS float*)sl; LAS int* Iw = (LAS int*)(sl + 4096);
    LAS bf16_t* Pb = (LAS bf16_t*)(sl + 5120);
    LAS bf16_t* Vs = (LAS bf16_t*)(sl + 7168);
    const bf16_t* Q = (const bf16_t*)(a.ws + OFF_Q); const bf16_t* K = (const bf16_t*)(a.ws + OFF_K); const bf16_t* V = (const bf16_t*)(a.ws + OFF_V);
    const bf16_t* AG = (const bf16_t*)(a.ws + OFF_AG); bf16_t* MIX = (bf16_t*)(a.ws + OFF_MIX);
    const int* IDX = (const int*)(a.ws + OFF_IDX) + (size_t)rq * 256;
    const int cnt = ((const int*)(a.ws + OFF_CNT))[rq];
#pragma unroll
    for (int i = 0; i < 4; ++i) { const int k = lane + 64 * i; Iw[k] = k < cnt ? IDX[k] : rq; }
    asm volatile("s_waitcnt lgkmcnt(0)" ::: "memory");
    const int hq = lane & 15, quad = lane >> 4;
    bf16x8 bq[4];
#pragma unroll
    for (int kk = 0; kk < 4; ++kk) { bq[kk] = (bf16x8){0, 0, 0, 0, 0, 0, 0, 0};
        if (hq < 4) bq[kk] = *(const bf16x8*)(Q + (size_t)rq * 1024 + (4 * g + hq) * 128 + kk * 32 + 8 * quad); }
    const float scale = 0.08838834764831845f;
    const bf16_t* kbase = K + g * 128 + 8 * quad;
    LAS float* pwl = Pw + 16 * quad + hq; asm volatile("" : "+v"(pwl));
    const LAS int* iwl = Iw + hq; asm volatile("" : "+v"(iwl));
    LAS float* pws = Pw + 4 * (lane >> 2) + (lane & 3); asm volatile("" : "+v"(pws));
    {
        bf16x8 kA[4][4], kB[4][4];
#define ATT_LOADK(dst, tg) do { _Pragma("unroll") for (int t = 0; t < 4; ++t) { const bf16_t* kp = kbase + (size_t)iwl[(tg) * 64 + t * 16] * 256; \
            _Pragma("unroll") for (int kk = 0; kk < 4; ++kk) dst[t][kk] = *(const bf16x8*)(kp + kk * 32); } } while (0)
#define ATT_QK(src, tg) do { _Pragma("unroll") for (int t = 0; t < 4; ++t) { f32x4 sc4 = (f32x4){0.f, 0.f, 0.f, 0.f}; \
            _Pragma("unroll") for (int kk = 0; kk < 4; ++kk) sc4 = mfma16(src[t][kk], bq[kk], sc4); \
            if (hq < 4) { _Pragma("unroll") for (int i = 0; i < 4; ++i) { const int key = ((tg) * 4 + t) * 16 + 4 * quad + i; pwl[(((tg) * 4 + t) * 16 + i) * 4] = (key < cnt) ? sc4[i] * scale : -INFINITY; } } } } while (0)
        ATT_LOADK(kA, 0);
        ATT_LOADK(kB, 1); ATT_QK(kA, 0); __builtin_amdgcn_sched_barrier(0);
        ATT_LOADK(kA, 2); ATT_QK(kB, 1); __builtin_amdgcn_sched_barrier(0);
        ATT_LOADK(kB, 3); ATT_QK(kA, 2); __builtin_amdgcn_sched_barrier(0);
        ATT_QK(kB, 3);
#undef ATT_LOADK
#undef ATT_QK
    }
    const bf16_t* vb = V + g * 128 + 8 * hq;
    u32x4 vr[4][8];
#define ATT_LOADV(c) do { _Pragma("unroll") for (int j = 0; j < 8; ++j) { const int kr = Iw[(c) * 32 + 4 * j + quad]; vr[(c) & 3][j] = *(const u32x4*)(vb + (size_t)kr * 256); } } while (0)
    ATT_LOADV(0); ATT_LOADV(1); ATT_LOADV(2);
    asm volatile("s_waitcnt lgkmcnt(0)" ::: "memory");
    float sum = 0.f;
    {
        float lg[16]; float mx = -INFINITY;
#pragma unroll
        for (int m = 0; m < 16; ++m) { lg[m] = pws[64 * m]; mx = fmaxf(mx, lg[m]); }
        mx = fmaxf(mx, __shfl_xor(mx, 4)); mx = fmaxf(mx, __shfl_xor(mx, 8)); mx = fmaxf(mx, __shfl_xor(mx, 16)); mx = fmaxf(mx, __shfl_xor(mx, 32));
        LAS bf16_t* pbs = Pb + (lane & 3) * 256 + (lane >> 2);
#pragma unroll
        for (int m = 0; m < 16; ++m) { const float p = __expf(lg[m] - mx); const bf16_t pb = f2bf(p); sum += bf2f(pb); pbs[16 * m] = pb; }
        sum += __shfl_xor(sum, 4); sum += __shfl_xor(sum, 8); sum += __shfl_xor(sum, 16); sum += __shfl_xor(sum, 32);
    }
    asm volatile("s_waitcnt lgkmcnt(0)" ::: "memory");
    f32x4 acc[8];
#pragma unroll
    for (int t = 0; t < 8; ++t) acc[t] = (f32x4){0.f, 0.f, 0.f, 0.f};
    const LAS bf16_t* pa_p = Pb + (lane & 3) * 256 + 8 * quad;
    const LAS bf16_t* vrd = Vs + (8 * quad) * 136 + hq;
    LAS bf16_t* vwr = Vs + quad * 136 + 8 * hq;
#pragma unroll
    for (int c = 0; c < 8; ++c) {
        asm volatile("" ::: "memory");
#pragma unroll
        for (int j = 0; j < 8; ++j) *(LAS u32x4*)(vwr + (4 * j) * 136) = vr[c & 3][j];
        asm volatile("" ::: "memory");
        if (c + 3 < 8) ATT_LOADV(c + 3);
        __builtin_amdgcn_sched_barrier(0);
        const bf16x8 pa = *(const LAS bf16x8*)(pa_p + c * 32);
#pragma unroll
        for (int t = 0; t < 8; ++t) {
            bf16x8 bv;
#pragma unroll
            for (int j = 0; j < 8; ++j) bv[j] = (short)vrd[j * 136 + 16 * t];
            acc[t] = mfma16(pa, bv, acc[t]);
        }
    }
#undef ATT_LOADV
    asm volatile("s_waitcnt lgkmcnt(0)" ::: "memory");
    if (quad == 0) {
#pragma unroll
        for (int t = 0; t < 8; ++t)
#pragma unroll
            for (int i = 0; i < 4; ++i) Pw[i * 128 + 16 * t + hq] = acc[t][i];
    }
    asm volatile("s_waitcnt lgkmcnt(0)" ::: "memory");
    const float isum = 1.f / __shfl(sum, quad);
    int ln3 = lane; asm volatile("" : "+v"(ln3));
    const int hd = ln3 >> 4, d0 = 8 * (ln3 & 15);
    const f32x4 o0 = *(const LAS f32x4*)(Pw + hd * 128 + d0), o1 = *(const LAS f32x4*)(Pw + hd * 128 + d0 + 4);
    float r[8] = {o0.x, o0.y, o0.z, o0.w, o1.x, o1.y, o1.z, o1.w};
    const int col = (4 * g + hd) * 128 + d0;
    float gt[8]; unpack8(*(const u32x4*)(AG + (size_t)rq * 1024 + col), gt);
#pragma unroll
    for (int e = 0; e < 8; ++e) r[e] *= isum * gt[e];
    if (ATTV == 0 || r[0] == 12345.678f) *(u32x4*)(MIX + (size_t)rq * DMIX + 3072 + col) = pack8(r);
}

#define XB_TMO      128
#define XB_XCNT(j)  (256  + 64 * (j))
#define XB_XSUB(j)  (1280 + 64 * (j))
#define XB_XGEN(j)  (2304 + 64 * (j))
#define XB_TOP      3328
#define XB_TOPGEN   3392
#define XCD_BAR_WORDS 3456
#define XB_SPIN_CAP (1u << 20)
static_assert(OFF_BAR + XCD_BAR_WORDS * 4 <= CTL_BYTES, "barrier words inside the memset region");
FI unsigned xb_ld(unsigned* p)              { return __hip_atomic_load(p, __ATOMIC_RELAXED, __HIP_MEMORY_SCOPE_AGENT); }
FI unsigned xb_add(unsigned* p, unsigned v) { return __hip_atomic_fetch_add(p, v, __ATOMIC_RELAXED, __HIP_MEMORY_SCOPE_AGENT); }
FI unsigned xb_xcc_id() { return (unsigned)__builtin_amdgcn_s_getreg((3 << 11) | 20) & 0xFu; }
#define XB_SPIN(cond, bar) do { unsigned _sp = 0; while (cond) { __builtin_amdgcn_s_sleep(1); \
    if ((++_sp & 255u) == 0u) { if (xb_ld(&(bar)[XB_TMO])) break; if (_sp > XB_SPIN_CAP) { atomicAdd(&(bar)[XB_TMO], 1u); break; } } } } while (0)
FI void xcd_barrier_complete(unsigned* bar, unsigned x, unsigned& nloc, unsigned& nx) {
    const unsigned G = gridDim.x;
    unsigned sum, cnt, mine, sp = 0u;
    for (;;) {
        sum = 0u; cnt = 0u; mine = 0u;
#pragma unroll
        for (unsigned j = 0; j < 16; ++j) { const unsigned c = xb_ld(&bar[XB_XCNT(j)]); sum += c; cnt += (c > 0u) ? 1u : 0u; mine = (j == x) ? c : mine; }
        if (sum == G) break;
        __builtin_amdgcn_s_sleep(1);
        if ((++sp & 255u) == 0u) { if (xb_ld(&bar[XB_TMO])) break; if (sp > XB_SPIN_CAP) { atomicAdd(&bar[XB_TMO], 1u); break; } }
    }
    nloc = mine > 0u ? mine : 1u; nx = cnt > 0u ? cnt : 1u;
}
FI void xcd_barrier(unsigned* bar, volatile LAS unsigned* st) {
    asm volatile("s_waitcnt vmcnt(0)" ::: "memory");
    __syncthreads();
    if (tid_l() == 0) {
        const unsigned x = xb_xcc_id();
        __builtin_amdgcn_s_waitcnt(0);
        unsigned nloc = st[0], nx = st[1];
        if (nloc == 0u) { xcd_barrier_complete(bar, x, nloc, nx); st[0] = nloc; st[1] = nx; }
        const unsigned old = xb_add(&bar[XB_XSUB(x)], 1u);
        const unsigned gen = old / nloc;
        if (old + 1u == (gen + 1u) * nloc) {
            __builtin_amdgcn_fence(__ATOMIC_RELEASE, "agent");
            asm volatile("s_waitcnt vmcnt(0)" ::: "memory");
            const unsigned og = xb_add(&bar[XB_TOP], 1u);
            const unsigned tg = og / nx;
            if (og + 1u == (tg + 1u) * nx) xb_add(&bar[XB_TOPGEN], 1u);
            else XB_SPIN(xb_ld(&bar[XB_TOPGEN]) == tg, bar);
            __builtin_amdgcn_fence(__ATOMIC_ACQUIRE, "agent");
            xb_add(&bar[XB_XGEN(x)], 1u);
            asm volatile("s_waitcnt vmcnt(0)" ::: "memory");
        } else {
            XB_SPIN(xb_ld(&bar[XB_XGEN(x)]) == gen, bar);
            __builtin_amdgcn_fence(__ATOMIC_ACQUIRE, "agent");
            asm volatile("s_waitcnt vmcnt(0)" ::: "memory");
        }
    }
    __syncthreads();
}
#define GRID_BAR() do { const Args _ab = load_args(); xcd_barrier((unsigned*)(_ab.ws + OFF_BAR), xst); } while (0)

FI void meta_rows_out(const Args& a) {
    const int tid = tid_l(), lane = tid & 63, w = tid >> 6;
    if (w != 0 || blockIdx.x >= 128) return;
    const bf16_t* A = (const bf16_t*)(a.ws + OFF_MIX) + (size_t)(ROW0 + (lane & 15)) * DMIX + 8 * (lane >> 4);
    const bf16_t* B = (const bf16_t*)(a.ws + OFF_WOUT) + (size_t)(16 * blockIdx.x + (lane & 15)) * DMIX + 8 * (lane >> 4);
    f32x4 acc0 = (f32x4){0.f, 0.f, 0.f, 0.f}, acc1 = acc0;
#pragma unroll 1
    for (int k0 = 0; k0 < DMIX; k0 += 512) {
        bf16x8 av[16], bv[16];
#pragma unroll
        for (int j = 0; j < 16; ++j) { av[j] = *(const bf16x8*)(A + k0 + 32 * j); bv[j] = *(const bf16x8*)(B + k0 + 32 * j); }
#pragma unroll
        for (int j = 0; j < 16; j += 2) { acc0 = mfma16(av[j], bv[j], acc0); acc1 = mfma16(av[j + 1], bv[j + 1], acc1); }
    }
    float* O = (float*)(a.ws + OFF_OUT);
#pragma unroll
    for (int i = 0; i < 4; ++i) O[(size_t)(ROW0 + 4 * (lane >> 4) + i) * DM + 16 * blockIdx.x + (lane & 15)] = acc0[i] + acc1[i];
}

#ifndef PHM
#define PHM 0xffff
#endif
#define DBL 0
#define ATTVAR 0
__global__ void __launch_bounds__(512, 2) fwd(Args a_unused) {
    extern __shared__ __attribute__((aligned(16))) unsigned char lds[];
    cg::grid_group grid = cg::this_grid();
    LAS unsigned char* ldsl = (LAS unsigned char*)lds;
    LAS int* slot = (LAS int*)(ldsl + LDS_BYTES - 16);

    volatile LAS unsigned* xst = (volatile LAS unsigned*)(ldsl + LDS_BYTES - 32);
    if (tid_l() < 2) xst[tid_l()] = 0u;
    __syncthreads();
    if (tid_l() == 0) { const Args a = load_args(); (void)xb_add((unsigned*)(a.ws + OFF_BAR) + XB_XCNT(xb_xcc_id()), 1u); }
    if (PHM & 1) {
        { const Args a = load_args(); rope_tables(a); }
        { const Args a = load_args(); convert_weights(a, 0, lds); }
        if (DBL & 256) { const Args a = load_args(); convert_weights(a, 0, lds); }
        { const Args a = load_args(); convert_pool_w(a, lds); }
        { const Args a = load_args(); row_pass(a, 0, 0); }
    }
    grid.sync();

    for (int layer = 0; layer < 2; ++layer) {
        if (PHM & 2) {
            const Args a = load_args();
            pg8::Gemm g{(const bf16_t*)(a.ws + OFF_U), (const bf16_t*)(a.ws + OFF_WIN), MR, NP, DM};
            pg8::StaticOrder S; S.init(MR, NP, DM, (int)gridDim.x, (int)blockIdx.x);
            Epi1 E{a.ws, a.in[9] + layer * 32};
            pg8::gemm_phase<Epi1, pg8::StaticOrder, true, true>(ldsl, g, S, E);
            if (DBL & 64) { __syncthreads(); pg8::gemm_phase<Epi1, pg8::StaticOrder, true, true>(ldsl, g, S, E); }
        }
        GRID_BAR();
        {
            int nxt = 0;
            for (;;) {
                const Args a = load_args();
                const int it = next_item((unsigned*)(a.ws + OFF_CTL) + layer * 8 + 0, slot, nxt, 0);
                if (it < 260) ssd_s1(a, layer, it >> 2, it & 3, lds);
                else if (it < 260 + IDX_BLOCK_TASKS) indexer_block_task<0>(a, it - 260, lds);
                else if (it < 260 + IDX_BLOCK_TASKS + 264) pool_pre_item(a, it - 260 - IDX_BLOCK_TASKS);
                else break;
            }
#ifdef PROBE_IDX
            nxt = 0;
            for (;;) {
                const Args a = load_args();
                const int it = next_item((unsigned*)(a.ws + OFF_CTL) + layer * 8 + 6, slot, nxt, 0);
                if (it < IDX_BLOCK_TASKS) indexer_block_task<PROBE_IDX>(a, it, lds);
                else break;
            }
#endif
        }
        GRID_BAR();
        if (PHM & 32) {
            const Args a = load_args();
            pg8::Gemm g{(const bf16_t*)(a.ws + OFF_U), (const bf16_t*)(a.ws + OFF_PWT) + (size_t)layer * 4 * 65536, 4 * MR, 256, 256};
            pg8::PoolOrder S{(int)gridDim.x, (int)blockIdx.x};
            EpiPool E{(bf16_t*)(a.ws + OFF_MIX), (const bf16_t*)(a.ws + OFF_PG), a.in[6] + layer * 1024};
            pg8::gemm_phase<EpiPool, pg8::PoolOrder, false, true>(ldsl, g, S, E);
        }
        {
            int nxt = 0;
            for (;;) {
                const Args a = load_args();
                const int it = next_item((unsigned*)(a.ws + OFF_CTL) + layer * 8 + 1, slot, nxt, 0);
                if (it < 128) ssd_scan_item(a, it);
                else break;
            }
            const int lane = tid_l() & 63;
            const int wq = __builtin_amdgcn_readfirstlane(tid_l() >> 6);
            int nv = wave_fetch((unsigned*)(load_args().ws + OFF_CTL + 20480) + ((layer * 3 + 1) * 8 + wq) * 64, lane);
            for (;;) {
                const Args a = load_args();
                const int it = 8 * __builtin_amdgcn_readfirstlane(nv) + wq;
                if (it >= NTOK) break;
                nv = wave_fetch((unsigned*)(a.ws + OFF_CTL + 20480) + ((layer * 3 + 1) * 8 + wq) * 64, lane);
                topk_item(a, it, lds);
            }
        }
        GRID_BAR();
        {
            int nxt = 0;
            for (;;) {
                const Args a = load_args();
                const int it = next_item((unsigned*)(a.ws + OFF_CTL) + layer * 8 + 2, slot, nxt, 0);
                if (it < 260) ssd_s3(a, layer, it >> 2, it & 3, lds);
                else break;
            }
            __syncthreads();
            const int lane = tid_l() & 63;
            const int wq = __builtin_amdgcn_readfirstlane(tid_l() >> 6);
            int nv = wave_fetch((unsigned*)(load_args().ws + OFF_CTL + 20480) + ((layer * 3 + 2) * 8 + wq) * 64, lane);
            for (;;) {
                const Args a = load_args();
                const int it = 8 * __builtin_amdgcn_readfirstlane(nv) + wq;
                if (it >= NTOK * 2) break;
                nv = wave_fetch((unsigned*)(a.ws + OFF_CTL + 20480) + ((layer * 3 + 2) * 8 + wq) * 64, lane);
                attn_item<0>(a, it, lds);
            }
        }
        GRID_BAR();
        if (PHM & 1024) {
            const Args a = load_args();
            const int skip = 256;
            pg8::Gemm g{(const bf16_t*)(a.ws + OFF_MIX) + (size_t)skip * DMIX, (const bf16_t*)(a.ws + OFF_WOUT), MR - skip, DM, DMIX};
            pg8::StaticOrder S; S.init(MR - skip, DM, DMIX, (int)gridDim.x, (int)blockIdx.x);
            EpiOut E{(float*)(a.ws + OFF_OUT), skip};
            pg8::gemm_phase<EpiOut, pg8::StaticOrder, false, true>(ldsl, g, S, E);
            if (DBL & 128) { __syncthreads(); pg8::gemm_phase<EpiOut, pg8::StaticOrder, false, true>(ldsl, g, S, E); }
            if (layer == 0) meta_rows_out(a);
        }
        GRID_BAR();
        if (PHM & 2048) {
            if (layer == 0) { { const Args a = load_args(); row_pass(a, 1, 0); } { const Args a = load_args(); convert_weights(a, 1, lds); } }
            else { const Args a = load_args(); row_pass(a, 2, 1); }
        }
        if (layer == 0) GRID_BAR();
    }
}

extern "C" void kernel_launch(void* const* d_in, const int* in_sizes, int n_in, void* d_out, int out_size, void* d_ws, size_t ws_size, hipStream_t stream) {
    static int grid = 0;
    if (grid == 0) {
        int dev = 0, cus = 0, per_cu = 0;
        (void)hipGetDevice(&dev); (void)hipDeviceGetAttribute(&cus, hipDeviceAttributeMultiprocessorCount, dev);
        (void)hipFuncSetAttribute((const void*)fwd, hipFuncAttributeMaxDynamicSharedMemorySize, LDS_BYTES);
        (void)hipOccupancyMaxActiveBlocksPerMultiprocessor(&per_cu, (const void*)fwd, 512, LDS_BYTES);
        if (ws_size < WS_END || n_in != 14) { fprintf(stderr, "kernel_launch: ws_size %zu < %zu or n_in %d != 14\n", ws_size, (size_t)WS_END, n_in); grid = -1; return; }
        grid = cus > 0 ? cus : 256;
        (void)per_cu;
    }
    if (grid < 0) return;
    (void)hipMemsetAsync((char*)d_ws + OFF_CTL, 0, CTL_BYTES, stream);
    Args a{};
    for (int i = 0; i < 14; ++i) a.in[i] = (const float*)d_in[i];
    a.out = (float*)d_out; a.ws = (unsigned char*)d_ws;
    void* args[] = {&a};
    hipError_t e = hipLaunchCooperativeKernel((void*)fwd, dim3(grid), dim3(512), args, LDS_BYTES, stream);
    if (e != hipSuccess) fprintf(stderr, "cooperative launch failed: %s (grid %d)\n", hipGetErrorString(e), grid);
}
```

```cpp
#include <hip/hip_runtime.h>
#include <hip/hip_cooperative_groups.h>
#include <cstdio>
#include <cstdint>
#include <cmath>
namespace cg = cooperative_groups;

typedef unsigned short bf16_t;
typedef short bf16x8 __attribute__((ext_vector_type(8)));
typedef float f32x4 __attribute__((ext_vector_type(4)));
typedef float f32x16 __attribute__((ext_vector_type(16)));
typedef unsigned u32x4 __attribute__((ext_vector_type(4)));
typedef unsigned u32x2 __attribute__((ext_vector_type(2)));
#define LAS __attribute__((address_space(3)))
#define FI __device__ __forceinline__

constexpr int MR = 8448;
constexpr int ROW0 = 240;
constexpr int NTOK = 8208;
constexpr int DM = 2048;
constexpr int NP = 11008;
constexpr int DMIX = 4096;
constexpr int NCH = 65;
constexpr float EPS = 1e-6f;
constexpr int LDS_BYTES = 147456;

constexpr size_t OFF_CTL = 0;
constexpr size_t OFF_BAR = 4096;
constexpr size_t CTL_BYTES = 32768;
constexpr size_t OFF_WIN = CTL_BYTES;
constexpr size_t OFF_WOUT = OFF_WIN + (size_t)NP * DM * 2;
constexpr size_t OFF_PWT = OFF_WOUT + (size_t)DM * DMIX * 2;
constexpr size_t OFF_ROPEA = OFF_PWT + (size_t)2 * 4 * 65536 * 2;
constexpr size_t OFF_ROPEI = OFF_ROPEA + (size_t)MR * 16 * 4 * 2;
constexpr size_t OFF_H = OFF_ROPEI + (size_t)MR * 8 * 4 * 2;
constexpr size_t OFF_U = OFF_H + (size_t)MR * DM * 4;
constexpr size_t OFF_PG = OFF_U + (size_t)MR * DM * 2;
constexpr size_t OFF_ZS = OFF_PG + (size_t)MR * 1024 * 2;
constexpr size_t OFF_XBC = OFF_ZS + (size_t)MR * 2048 * 2;
constexpr size_t OFF_PV = OFF_XBC + (size_t)MR * 3072 * 2;
constexpr size_t OFF_MIX = OFF_XBC;
constexpr size_t OFF_DT = OFF_PV + (size_t)MR * 1024 * 2;
constexpr size_t OFF_Q = OFF_DT + (size_t)MR * 32 * 4;
constexpr size_t OFF_K = OFF_Q + (size_t)MR * 1024 * 2;
constexpr size_t OFF_V = OFF_K + (size_t)MR * 256 * 2;
constexpr size_t OFF_AG = OFF_V + (size_t)MR * 256 * 2;
constexpr size_t OFF_IQ = OFF_AG + (size_t)MR * 1024 * 2;
constexpr size_t OFF_IK = OFF_IQ + (size_t)MR * 1024 * 2;
constexpr size_t OFF_IW = OFF_IK + (size_t)MR * 64 * 2;
constexpr size_t OFF_XS = OFF_IW + (size_t)MR * 16 * 4;
constexpr size_t OFF_CM = OFF_XS + (size_t)MR * 2048 * 2;
constexpr size_t OFF_CSB = OFF_CM + (size_t)MR * 512 * 2;
constexpr size_t OFF_YD = OFF_CSB + (size_t)MR * 32 * 4;
constexpr size_t OFF_OUT = OFF_YD;
constexpr size_t OFF_HS = OFF_YD + (size_t)MR * 2048 * 2;
static_assert((size_t)NCH * 32 * 64 * 128 * 2 <= (size_t)MR * 2048 * 2, "HS fits behind the bf16 y_diag");
constexpr size_t OFF_ST = OFF_YD + (size_t)MR * 2048 * 4;
constexpr size_t OFF_CD = OFF_ST + (size_t)NCH * 32 * 64 * 128 * 4;
constexpr size_t OFF_SC = OFF_CD + 8448;
constexpr size_t OFF_IDX = OFF_SC + (size_t)1089 * 256 * 128 * 4;
constexpr size_t OFF_CNT = OFF_IDX + (size_t)MR * 256 * 4;
constexpr size_t WS_END = OFF_CNT + (size_t)MR * 4;
static_assert(OFF_PV + (size_t)MR * 1024 * 2 - OFF_XBC == (size_t)MR * DMIX * 2, "MIX alias");
static_assert(WS_END <= 711983104ull, "workspace");

struct Args { const float* in[14]; float* out; unsigned char* ws; };
__device__ __forceinline__ Args load_args() {
#if defined(__HIP_DEVICE_COMPILE__)
    const __attribute__((address_space(4))) Args* p = (const __attribute__((address_space(4))) Args*)__builtin_amdgcn_kernarg_segment_ptr();
    asm volatile("" : "+s"(p));
    Args r;
#pragma unroll
    for (int i = 0; i < 14; ++i) r.in[i] = p->in[i];
    r.out = p->out; r.ws = p->ws;
    return r;
#else
    return Args{};
#endif
}

FI unsigned cvt_pk_bf16(float lo, float hi) { unsigned r; asm volatile("v_cvt_pk_bf16_f32 %0, %1, %2" : "=v"(r) : "v"(lo), "v"(hi)); return r; }
FI bf16_t f2bf(float f) { return (bf16_t)(cvt_pk_bf16(f, 0.f) & 0xffffu); }
FI float bf2f(bf16_t h) { return __uint_as_float((unsigned)h << 16); }
FI float bflo(unsigned w) { return __uint_as_float(w << 16); }
FI float bfhi(unsigned w) { return __uint_as_float(w & 0xffff0000u); }
FI float silu_f(float x) { return x / (1.f + __expf(-x)); }
FI float wave_sum(float v) {
#pragma unroll
    for (int o = 1; o < 64; o <<= 1) v += __shfl_xor(v, o);
    return v;
}
FI void unpack8(u32x4 w, float* o) { o[0] = bflo(w.x); o[1] = bfhi(w.x); o[2] = bflo(w.y); o[3] = bfhi(w.y); o[4] = bflo(w.z); o[5] = bfhi(w.z); o[6] = bflo(w.w); o[7] = bfhi(w.w); }
FI u32x4 pack8(const float* v) { u32x4 w; w.x = cvt_pk_bf16(v[0], v[1]); w.y = cvt_pk_bf16(v[2], v[3]); w.z = cvt_pk_bf16(v[4], v[5]); w.w = cvt_pk_bf16(v[6], v[7]); return w; }
FI f32x16 mfma32(bf16x8 a, bf16x8 b, f32x16 c) { return __builtin_amdgcn_mfma_f32_32x32x16_bf16(a, b, c, 0, 0, 0); }
FI f32x4 mfma16(bf16x8 a, bf16x8 b, f32x4 c) { return __builtin_amdgcn_mfma_f32_16x16x32_bf16(a, b, c, 0, 0, 0); }

FI int tid_l() { int t = threadIdx.x; asm volatile("" : "+v"(t)); return t; }
FI int next_item(unsigned* ctr, LAS int* slot, int& nxt, int total) {
    __syncthreads();
    if (tid_l() == 0) *slot = (int)atomicAdd(ctr, 1u);
    __syncthreads();
    return *slot;
}
FI int wave_fetch(unsigned* ctr, int lane) { int v = 0; if (lane == 0) v = (int)atomicAdd(ctr, 1u); return v; }
FI int first_item(unsigned* ctr) { return 0; }

namespace pg8 {
constexpr int BM = 256, BK = 64, HALF = 128, HTB = HALF * BK * 2, STAGE_BYTES = 8 * HTB, NXCD = 8, WGM = 8;
FI int lds_byte(int r, int c) { const int st = (r >> 4) * 2 + (c >> 5), rr = r & 15, cc = c & 31, ob = rr * 64 + cc * 2; return st * 1024 + (ob ^ (((ob >> 9) & 1) << 5)); }
FI void stage_rc(int b, int& R, int& C) { const int st = b / 1024, sb = b % 1024, swz = sb ^ (((sb >> 9) & 1) << 5); R = (st >> 1) * 16 + swz / 64; C = (st & 1) * 32 + (swz % 64) / 2; }
FI int perm32(int rho) { const int n = rho >> 4, i = rho & 15; return 8 * (i >> 2) + 4 * n + (i & 3); }
struct Unit { int pm, pn; };
struct Gemm { const bf16_t* A; const bf16_t* Bt; int M, N, K; };

struct StaticOrder {
    int nM, nN, nwg, G, c, K;
    FI void init(int M, int N, int K_, int G_, int c_) { nM = M / BM; nN = N / BM; nwg = nM * nN; G = G_; c = c_; K = K_; }
    FI bool next(int i, Unit& u) const {
        const long L = (long)i * G + c; if (L >= nwg) return false;
        int wgid = (int)L; { const int q = nwg / NXCD, r = nwg % NXCD, xcd = wgid % NXCD, off = wgid / NXCD; wgid = (xcd < r ? xcd * (q + 1) : r * (q + 1) + (xcd - r) * q) + off; }
        const int nig = WGM * nN, gid = wgid / nig, fm = gid * WGM, gsz = (nM - fm) < WGM ? (nM - fm) : WGM;
        u.pm = fm + ((wgid % nig) % gsz); u.pn = (wgid % nig) / gsz; return true;
    }
    FI size_t aoff(const Unit& u) const { return (size_t)u.pm * 512 * K; }
    FI size_t boff(const Unit& u) const { return (size_t)u.pn * 512 * K; }
};
struct PoolOrder {
    int G, c;
    FI bool next(int i, Unit& u) const { const int L = i * G + c; if (L >= 132) return false; u.pm = L; u.pn = 0; return true; }
    FI size_t aoff(const Unit& u) const { return (size_t)u.pm * 512 * 256; }
    FI size_t boff(const Unit& u) const { return (size_t)(u.pm / 33) * 65536 * 2; }
};

template <class Epi, class Sched, bool ALIGN_EPI = false, bool SP2 = false>
FI void gemm_phase(LAS unsigned char* lds, const Gemm g, const Sched& S, const Epi& E) {
    const int tid = tid_l(), wid = __builtin_amdgcn_readfirstlane(tid >> 6), lane = tid & 63, wr = wid >> 2, wc = wid & 3, fr = lane & 15, fq = lane >> 4;
    const int K = g.K, nt = K / BK;
    unsigned voffA[2], voffB[2];
#pragma unroll
    for (int i = 0; i < 2; ++i) { int R, C; stage_rc(tid * 16 + i * 8192, R, C); const int Rb = Epi::PERM ? ((R & ~31) + perm32(R & 31)) : R;
        voffA[i] = (unsigned)(R * K + C) * 2u; voffB[i] = (unsigned)(Rb * K + C) * 2u; }
    const size_t kstep = (size_t)(BK * 2);
    const size_t hstep = (size_t)HALF * K * 2;
    const unsigned ldsw = (unsigned)wid * 1024u;
    const int aoff = lds_byte(wr * 64 + fr, fq * 8), boff = lds_byte(wc * 32 + fr, fq * 8);
#define PG8_SA(b, h) (((b) * 2 + (h)) * HTB)
#define PG8_SB(b, h) ((4 + (b) * 2 + (h)) * HTB)
#define PG8_STAGE(bufoff, gbase, voff) do { _Pragma("unroll") for (int _i = 0; _i < 2; ++_i) \
        __builtin_amdgcn_global_load_lds((const unsigned*)((const char*)(gbase) + (voff)[_i]), (LAS unsigned*)(lds + (bufoff) + ldsw + _i * 8192), 16, 0, 0); } while (0)
#define PG8_LDA(dst, b, h) do { _Pragma("unroll") for (int m = 0; m < 4; ++m) _Pragma("unroll") for (int k = 0; k < 2; ++k) dst[m][k] = *(const LAS bf16x8*)(lds + PG8_SA(b, h) + aoff + m * 2048 + k * 1024); } while (0)
#define PG8_LDB(dst, b, h) do { _Pragma("unroll") for (int n = 0; n < 2; ++n) _Pragma("unroll") for (int k = 0; k < 2; ++k) dst[n][k] = *(const LAS bf16x8*)(lds + PG8_SB(b, h) + boff + n * 2048 + k * 1024); } while (0)
#define PG8_MMA(ai, bj, At, Bt) do { __builtin_amdgcn_s_setprio(1); _Pragma("unroll") for (int m = 0; m < 4; ++m) _Pragma("unroll") for (int n = 0; n < 2; ++n) _Pragma("unroll") for (int k = 0; k < 2; ++k) \
        acc[ai][bj][m][n] = __builtin_amdgcn_mfma_f32_16x16x32_bf16(Bt[n][k], At[m][k], acc[ai][bj][m][n], 0, 0, 0); __builtin_amdgcn_s_setprio(0); } while (0)
#define PG8_WAIT_V(n) asm volatile("s_waitcnt vmcnt(" #n ")" ::: "memory")
#define PG8_WAIT_L(n) asm volatile("s_waitcnt lgkmcnt(" #n ")" ::: "memory")
#define PG8_BAR __builtin_amdgcn_s_barrier()
#define PG8_SCHED __builtin_amdgcn_sched_barrier(0)
    Unit cur, nxt; int ui = 0;
    if (!S.next(0, cur)) return;
    f32x4 acc[2][2][4][2];
#pragma unroll
    for (int a = 0; a < 2; ++a)
#pragma unroll
        for (int b = 0; b < 2; ++b)
#pragma unroll
            for (int m = 0; m < 4; ++m)
#pragma unroll
                for (int n = 0; n < 2; ++n) acc[a][b][m][n] = (f32x4){0.f, 0.f, 0.f, 0.f};
    bf16x8 At[4][2], B0[2][2], B1[2][2];
    const char* cA = (const char*)g.A + S.aoff(cur); const char* cB = (const char*)g.Bt + S.boff(cur);
    if constexpr (SP2) {
        PG8_STAGE(PG8_SB(0, 0), cB, voffB); PG8_STAGE(PG8_SB(0, 1), cB + hstep, voffB); PG8_STAGE(PG8_SA(0, 0), cA, voffA); PG8_STAGE(PG8_SA(0, 1), cA + hstep, voffA);
        if (wr == 1) PG8_BAR;
        PG8_WAIT_V(2); PG8_BAR;
        PG8_STAGE(PG8_SB(1, 0), cB + kstep, voffB); PG8_STAGE(PG8_SA(1, 0), cA + kstep, voffA); PG8_STAGE(PG8_SB(1, 1), cB + hstep + kstep, voffB);
        PG8_WAIT_V(6); PG8_BAR;
    } else {
    PG8_STAGE(PG8_SB(0, 0), cB, voffB); PG8_STAGE(PG8_SA(0, 0), cA, voffA); PG8_STAGE(PG8_SB(0, 1), cB + hstep, voffB); PG8_STAGE(PG8_SA(0, 1), cA + hstep, voffA);
    if (wr == 1) PG8_BAR;
    PG8_WAIT_V(4); PG8_BAR;
    PG8_STAGE(PG8_SB(1, 0), cB + kstep, voffB); PG8_STAGE(PG8_SA(1, 0), cA + kstep, voffA); PG8_STAGE(PG8_SB(1, 1), cB + hstep + kstep, voffB);
    PG8_WAIT_V(6); PG8_BAR;
    }
    for (;;) {
        const bool has_next = S.next(ui + 1, nxt);
        const char* nA = has_next ? (const char*)g.A + S.aoff(nxt) : cA; const char* nB = has_next ? (const char*)g.Bt + S.boff(nxt) : cB;
        for (int t = 0; t < nt; t += 2) {
            const bool last = (t == nt - 2);
            const char* a1 = cA + (size_t)(t + 1) * kstep;
            const char* a2 = last ? nA : cA + (size_t)(t + 2) * kstep; const char* b2 = last ? nB : cB + (size_t)(t + 2) * kstep;
            const char* a3 = a2 + kstep; const char* b3 = b2 + kstep;
            if constexpr (SP2) {
            PG8_LDB(B0, 0, 0); PG8_LDB(B1, 0, 1); PG8_SCHED; PG8_LDA(At, 0, 0); PG8_STAGE(PG8_SA(1, 1), a1 + hstep, voffA);
            PG8_WAIT_V(8); PG8_WAIT_L(0); PG8_BAR; PG8_MMA(0, 0, At, B0); PG8_MMA(0, 1, At, B1); PG8_BAR; PG8_SCHED;
            PG8_LDA(At, 0, 1); PG8_STAGE(PG8_SB(0, 0), b2, voffB); PG8_STAGE(PG8_SB(0, 1), b2 + hstep, voffB); PG8_STAGE(PG8_SA(0, 0), a2, voffA);
            PG8_WAIT_V(8); PG8_WAIT_L(0); PG8_BAR; PG8_MMA(1, 0, At, B0); PG8_MMA(1, 1, At, B1); PG8_BAR; PG8_SCHED;
            PG8_LDB(B0, 1, 0); PG8_LDB(B1, 1, 1); PG8_SCHED; PG8_LDA(At, 1, 0); PG8_STAGE(PG8_SA(0, 1), a2 + hstep, voffA);
            PG8_WAIT_V(8); PG8_WAIT_L(0); PG8_BAR; PG8_MMA(0, 0, At, B0); PG8_MMA(0, 1, At, B1); PG8_BAR; PG8_SCHED;
            PG8_LDA(At, 1, 1); PG8_STAGE(PG8_SB(1, 0), b3, voffB); PG8_STAGE(PG8_SB(1, 1), b3 + hstep, voffB); PG8_STAGE(PG8_SA(1, 0), a3, voffA);
            PG8_WAIT_V(8); PG8_WAIT_L(0); PG8_BAR; PG8_MMA(1, 0, At, B0); PG8_MMA(1, 1, At, B1); PG8_BAR; PG8_SCHED;
            } else {
            PG8_LDB(B0, 0, 0); PG8_SCHED; PG8_LDA(At, 0, 0); PG8_STAGE(PG8_SA(1, 1), a1 + hstep, voffA);
            PG8_WAIT_L(8); PG8_BAR; PG8_WAIT_L(0); PG8_MMA(0, 0, At, B0); PG8_BAR; PG8_SCHED;
            PG8_LDB(B1, 0, 1); PG8_STAGE(PG8_SB(0, 0), b2, voffB);
            PG8_BAR; PG8_WAIT_L(0); PG8_MMA(0, 1, At, B1); PG8_BAR;
            PG8_LDA(At, 0, 1); PG8_STAGE(PG8_SA(0, 0), a2, voffA);
            PG8_BAR; PG8_WAIT_L(0); PG8_MMA(1, 0, At, B0); PG8_BAR; PG8_SCHED;
            PG8_STAGE(PG8_SB(0, 1), b2 + hstep, voffB);
            PG8_WAIT_V(6); PG8_BAR; PG8_MMA(1, 1, At, B1); PG8_BAR;
            PG8_LDB(B0, 1, 0); PG8_SCHED; PG8_LDA(At, 1, 0); PG8_STAGE(PG8_SA(0, 1), a2 + hstep, voffA);
            PG8_WAIT_L(8); PG8_BAR; PG8_WAIT_L(0); PG8_MMA(0, 0, At, B0); PG8_BAR; PG8_SCHED;
            PG8_LDB(B1, 1, 1); PG8_STAGE(PG8_SB(1, 0), b3, voffB);
            PG8_BAR; PG8_WAIT_L(0); PG8_MMA(0, 1, At, B1); PG8_BAR;
            PG8_LDA(At, 1, 1); PG8_STAGE(PG8_SA(1, 0), a3, voffA);
            PG8_BAR; PG8_WAIT_L(0); PG8_MMA(1, 0, At, B0); PG8_BAR; PG8_SCHED;
            PG8_STAGE(PG8_SB(1, 1), b3 + hstep, voffB);
            PG8_WAIT_V(6); PG8_BAR; PG8_MMA(1, 1, At, B1); PG8_BAR;
            }
        }
        if constexpr (ALIGN_EPI) { if (wr == 0) PG8_BAR; }
        E(acc, cur, wr, wc, fr, fq);
        if (!has_next) break;
#pragma unroll
        for (int a = 0; a < 2; ++a)
#pragma unroll
            for (int b = 0; b < 2; ++b)
#pragma unroll
                for (int m = 0; m < 4; ++m)
#pragma unroll
                    for (int n = 0; n < 2; ++n) acc[a][b][m][n] = (f32x4){0.f, 0.f, 0.f, 0.f};
        cur = nxt; cA = nA; cB = nB; ++ui;
        if constexpr (ALIGN_EPI) { if (wr == 1) PG8_BAR; }
    }
    PG8_WAIT_V(0);
    if constexpr (!ALIGN_EPI) { if (wr == 0) PG8_BAR; }
    PG8_BAR;
#undef PG8_SA
#undef PG8_SB
#undef PG8_STAGE
#undef PG8_LDA
#undef PG8_LDB
#undef PG8_MMA
#undef PG8_WAIT_V
#undef PG8_WAIT_L
#undef PG8_BAR
#undef PG8_SCHED
}
}

struct Epi1 {
    static constexpr bool PERM = true;
    unsigned char* ws; const float* dt_bias;
    FI void operator()(const f32x4 (&acc)[2][2][4][2], const pg8::Unit& u, int wr, int wc, int fr, int fq) const {
        unsigned char* ws = this->ws; asm volatile("" : "+s"(ws));
        const float* dt_bias = this->dt_bias; asm volatile("" : "+s"(dt_bias));
        const int pn = u.pn;
        int mode, ld, cb; size_t off;
        if (pn < 4) { mode = 0; off = OFF_PV; ld = 1024; cb = pn * 256; }
        else if (pn < 8) { mode = 1; off = OFF_PG; ld = 1024; cb = (pn - 4) * 256; }
        else if (pn < 16) { mode = 1; off = OFF_ZS; ld = 2048; cb = (pn - 8) * 256; }
        else if (pn < 28) { mode = 0; off = OFF_XBC; ld = 3072; cb = (pn - 16) * 256; }
        else if (pn < 32) { mode = 2; off = OFF_Q; ld = 1024; cb = (pn - 28) * 256; }
        else if (pn == 32) { mode = 2; off = OFF_K; ld = 256; cb = 0; }
        else if (pn == 33) { mode = 0; off = OFF_V; ld = 256; cb = 0; }
        else if (pn < 38) { mode = 1; off = OFF_AG; ld = 1024; cb = (pn - 34) * 256; }
        else if (pn < 42) { mode = 3; off = OFF_IQ; ld = 1024; cb = (pn - 38) * 256; }
        else { mode = 4; off = OFF_IK; ld = 64; cb = 0; }
        bf16_t* dst = (bf16_t*)(ws + off);
        const float* cosA = (const float*)(ws + OFF_ROPEA); const float* sinA = cosA + MR * 16;
        const float* cosI = (const float*)(ws + OFF_ROPEI); const float* sinI = cosI + MR * 8;
        float* DT = (float*)(ws + OFF_DT); float* IW = (float*)(ws + OFF_IW);
        const int row0 = u.pm * 256 + wr * 64 + fr;
#pragma unroll
        for (int ai = 0; ai < 2; ++ai)
#pragma unroll
            for (int m = 0; m < 4; ++m) {
                const int row = row0 + ai * 128 + m * 16;
#pragma unroll
                for (int bj = 0; bj < 2; ++bj) {
                    const int cl = bj * 128 + wc * 32 + 8 * fq;
                    float v[8];
#pragma unroll
                    for (int e = 0; e < 4; ++e) { v[e] = acc[ai][bj][m][0][e]; v[4 + e] = acc[ai][bj][m][1][e]; }
                    if (mode == 1) {
#pragma unroll
                        for (int e = 0; e < 8; ++e) v[e] = silu_f(v[e]);
                    } else if (mode == 2) {
                        if (wc == 0) {
                            const f32x4 c0 = *(const f32x4*)(cosA + row * 16 + 8 * (fq & 1)), c1 = *(const f32x4*)(cosA + row * 16 + 8 * (fq & 1) + 4);
                            const f32x4 s0 = *(const f32x4*)(sinA + row * 16 + 8 * (fq & 1)), s1 = *(const f32x4*)(sinA + row * 16 + 8 * (fq & 1) + 4);
#pragma unroll
                            for (int e = 0; e < 8; ++e) { const float o = __shfl_xor(v[e], 32); const float c = e < 4 ? c0[e & 3] : c1[e & 3], s = e < 4 ? s0[e & 3] : s1[e & 3];
                                v[e] = (fq < 2) ? v[e] * c - o * s : v[e] * c + o * s; }
                        }
                    } else if (mode == 3) {
                        if ((wc & 1) == 0) {
                            const f32x4 c0 = *(const f32x4*)(cosI + row * 8), c1 = *(const f32x4*)(cosI + row * 8 + 4);
                            const f32x4 s0 = *(const f32x4*)(sinI + row * 8), s1 = *(const f32x4*)(sinI + row * 8 + 4);
#pragma unroll
                            for (int e = 0; e < 8; ++e) { const float o = __shfl_xor(v[e], 16); const float c = e < 4 ? c0[e & 3] : c1[e & 3], s = e < 4 ? s0[e & 3] : s1[e & 3];
                                const float r = (fq == 0) ? v[e] * c - o * s : v[e] * c + o * s; v[e] = (fq < 2) ? r : v[e]; }
                        }
                    }
                    if (mode != 4) { *(u32x4*)(dst + (size_t)row * ld + cb + cl) = pack8(v); }
                    else if (bj == 0) {
                        if (wc == 0) {
#pragma unroll
                            for (int e = 0; e < 8; ++e) { const float x = v[e] + dt_bias[8 * fq + e]; float ln2c = 0.69314718f; asm volatile("" : "+v"(ln2c));
                                const float sp = x > 20.f ? x : __log2f(1.f + __expf(x)) * ln2c; v[e] = row >= ROW0 ? sp : 0.f; }
                            *(f32x4*)(DT + row * 32 + 8 * fq) = (f32x4){v[0], v[1], v[2], v[3]}; *(f32x4*)(DT + row * 32 + 8 * fq + 4) = (f32x4){v[4], v[5], v[6], v[7]};
                        } else if (wc == 1) {
                            const f32x4 c0 = *(const f32x4*)(cosI + row * 8), c1 = *(const f32x4*)(cosI + row * 8 + 4);
                            const f32x4 s0 = *(const f32x4*)(sinI + row * 8), s1 = *(const f32x4*)(sinI + row * 8 + 4);
#pragma unroll
                            for (int e = 0; e < 8; ++e) { const float o = __shfl_xor(v[e], 16); const float c = e < 4 ? c0[e & 3] : c1[e & 3], s = e < 4 ? s0[e & 3] : s1[e & 3];
                                const float r = (fq == 0) ? v[e] * c - o * s : v[e] * c + o * s; v[e] = (fq < 2) ? r : v[e]; }
                            *(u32x4*)(dst + (size_t)row * 64 + 8 * fq) = pack8(v);
                        } else if (wc == 2) {
                            *(u32x4*)(dst + (size_t)row * 64 + 32 + 8 * fq) = pack8(v);
                        } else if (fq < 2) {
                            const float sc = 0.125f * 0.25f;
                            *(f32x4*)(IW + row * 16 + 8 * fq) = (f32x4){v[0] * sc, v[1] * sc, v[2] * sc, v[3] * sc}; *(f32x4*)(IW + row * 16 + 8 * fq + 4) = (f32x4){v[4] * sc, v[5] * sc, v[6] * sc, v[7] * sc};
                        }
                    }
                }
            }
    }
};
struct EpiOut {
    static constexpr bool PERM = true;
    float* O; int rowoff;
    FI void operator()(const f32x4 (&acc)[2][2][4][2], const pg8::Unit& u, int wr, int wc, int fr, int fq) const {
        float* O = this->O; asm volatile("" : "+s"(O));
        const int row0 = u.pm * 256 + wr * 64 + fr + rowoff;
#pragma unroll
        for (int ai = 0; ai < 2; ++ai)
#pragma unroll
            for (int m = 0; m < 4; ++m)
#pragma unroll
                for (int bj = 0; bj < 2; ++bj) {
                    float* p = O + (size_t)(row0 + ai * 128 + m * 16) * DM + u.pn * 256 + bj * 128 + wc * 32 + 8 * fq;
                    *(f32x4*)p = acc[ai][bj][m][0]; *(f32x4*)(p + 4) = acc[ai][bj][m][1];
                    __builtin_amdgcn_sched_barrier(0);
                }
    }
};
struct EpiPool {
    static constexpr bool PERM = true;
    bf16_t* MIX; const bf16_t* PG; const float* pscale;
    FI void operator()(const f32x4 (&acc)[2][2][4][2], const pg8::Unit& u, int wr, int wc, int fr, int fq) const {
        bf16_t* MIX = this->MIX; asm volatile("" : "+s"(MIX));
        const bf16_t* PG = this->PG; asm volatile("" : "+s"(PG));
        const float* pscale = this->pscale; asm volatile("" : "+s"(pscale));
        const int grp = u.pm / 33, row0 = (u.pm % 33) * 256 + wr * 64 + fr;
#pragma unroll
        for (int ai = 0; ai < 2; ++ai)
#pragma unroll
            for (int m = 0; m < 4; ++m)
#pragma unroll
                for (int bj = 0; bj < 2; ++bj) {
                    const int row = row0 + ai * 128 + m * 16, col = grp * 256 + bj * 128 + wc * 32 + 8 * fq;
                    float g[8]; unpack8(*(const u32x4*)(PG + (size_t)row * 1024 + col), g);
                    const f32x4 p0 = *(const f32x4*)(pscale + col), p1 = *(const f32x4*)(pscale + col + 4);
                    float v[8];
#pragma unroll
                    for (int e = 0; e < 4; ++e) { v[e] = acc[ai][bj][m][0][e] * p0[e] * g[e]; v[4 + e] = acc[ai][bj][m][1][e] * p1[e] * g[4 + e]; }
                    *(u32x4*)(MIX + (size_t)row * DMIX + col) = pack8(v);
                    __builtin_amdgcn_sched_barrier(0);
                }
    }
};

FI int src_col_win(int np) {
    if (np < 7168) return np;
    if (np < 10752) return np + 32;
    if (np < 10784) return 7168 + (np - 10752);
    if (np < 10864) return np;
    return -1;
}
template <bool MAP>
FI void transpose_item(const float* W, int K, int N, bf16_t* WT, float* scr, int item, int nblk, int lane) {
    const int kb = item / nblk, nb = item % nblk, k0 = 64 * kb, n0 = 32 * nb;
    int sc = n0 + (lane & 31); if (MAP) sc = src_col_win(sc);
    float tv[32];
#pragma unroll
    for (int i = 0; i < 32; ++i) { const int kk = 2 * i + (lane >> 5); tv[i] = sc >= 0 ? __builtin_nontemporal_load(&W[(size_t)(k0 + kk) * N + sc]) : 0.f; }
#pragma unroll
    for (int i = 0; i < 32; ++i) { const int kk = 2 * i + (lane >> 5); scr[kk * 33 + (lane & 31)] = tv[i]; }
    asm volatile("s_waitcnt lgkmcnt(0)" ::: "memory");
    const int c = lane & 7;
#pragma unroll
    for (int j = 0; j < 4; ++j) { const int n = (lane >> 3) + 8 * j; const float* s = scr + (8 * c) * 33 + n;
        u32x4 o; o.x = cvt_pk_bf16(s[0 * 33], s[1 * 33]); o.y = cvt_pk_bf16(s[2 * 33], s[3 * 33]); o.z = cvt_pk_bf16(s[4 * 33], s[5 * 33]); o.w = cvt_pk_bf16(s[6 * 33], s[7 * 33]);
        *(u32x4*)(WT + (size_t)(n0 + n) * K + k0 + 8 * c) = o; }
    asm volatile("s_waitcnt lgkmcnt(0)" ::: "memory");
}
FI void convert_weights(const Args& a, int layer, unsigned char* lds) {
    const int tid = tid_l(), lane = tid & 63, w = tid >> 6;
    float* scr = (float*)(lds + w * 16384);
    const int gw = blockIdx.x * 8 + w, NGW = gridDim.x * 8;
    constexpr int I_IN = (DM / 64) * (NP / 32), I_OUT = (DMIX / 64) * (DM / 32);
    const float* win = a.in[4] + (size_t)layer * DM * 10864; const float* wout = a.in[13] + (size_t)layer * DMIX * DM;
    bf16_t* WIN = (bf16_t*)(a.ws + OFF_WIN); bf16_t* WOUT = (bf16_t*)(a.ws + OFF_WOUT);
#pragma unroll 1
    for (int it = gw; it < I_IN + I_OUT; it += NGW) {
        if (it < I_IN) transpose_item<true>(win, DM, 10864, WIN, scr, it, NP / 32, lane);
        else transpose_item<false>(wout, DMIX, DM, WOUT, scr, it - I_IN, DM / 32, lane);
    }
}
FI void convert_pool_w(const Args& a, unsigned char* lds) {
    const int tid = tid_l(), lane = tid & 63, w = tid >> 6;
    float* scr = (float*)(lds + w * 16384);
    const int gw = blockIdx.x * 8 + w, NGW = gridDim.x * 8;
    bf16_t* PWT = (bf16_t*)(a.ws + OFF_PWT);
#pragma unroll 1
    for (int it = gw; it < 8 * 32; it += NGW) { const int mat = it >> 5;
        transpose_item<false>(a.in[5] + (size_t)mat * 65536, 256, 256, PWT + (size_t)mat * 65536, scr, it & 31, 8, lane); }
}
FI void rope_tables(const Args& a) {
    float* cosA = (float*)(a.ws + OFF_ROPEA); float* sinA = cosA + MR * 16;
    float* cosI = (float*)(a.ws + OFF_ROPEI); float* sinI = cosI + MR * 8;
    const int gt = blockIdx.x * 512 + tid_l(), NT = gridDim.x * 512;
#pragma unroll 1
    for (int i = gt; i < MR * 24; i += NT) {
        const int row = i / 24, j = i % 24; const int pos = row >= ROW0 ? row - ROW0 : 0;
        const float ex = j < 16 ? -(float)j * (2.0f / 32.0f) : -(float)(j - 16) * (2.0f / 16.0f);
        const float inv = exp2f(ex * 18.931568569324174f);
        const float ang = (float)pos * inv;
        double rev = (double)ang * 0.15915494309189535; rev -= rint(rev);
        const float rf = (float)rev;
        const float cs = __builtin_amdgcn_cosf(rf), sn = __builtin_amdgcn_sinf(rf);
        if (j < 16) { cosA[row * 16 + j] = cs; sinA[row * 16 + j] = sn; } else { cosI[row * 8 + j - 16] = cs; sinI[row * 8 + j - 16] = sn; }
    }
}
FI void row_pass(const Args& a, int mode, int layer) {
    const int tid = tid_l(), lane = tid & 63, w = tid >> 6;
    const int gw = blockIdx.x * 8 + w, NGW = gridDim.x * 8;
    float* H = (float*)(a.ws + OFF_H); bf16_t* U = (bf16_t*)(a.ws + OFF_U); const float* OUT = (const float*)(a.ws + OFF_OUT);
    const float* postw = a.in[3] + (size_t)layer * DM;
    const float* prew = a.in[2] + (size_t)(mode == 0 ? 0 : layer + 1) * DM;
#pragma unroll 1
    for (int row = gw; row < MR; row += NGW) {
        if (row < ROW0) {
            if (mode != 2) {
#pragma unroll
                for (int j = 0; j < 8; ++j) { if (mode == 0) *(f32x4*)(H + (size_t)row * DM + 4 * lane + 256 * j) = (f32x4){0.f, 0.f, 0.f, 0.f};
                    *(u32x2*)(U + (size_t)row * DM + 4 * lane + 256 * j) = (u32x2){0u, 0u}; }
            }
            continue;
        }
        if (mode == 2 && row < 256) continue;
        f32x4 h[8];
        if (mode == 0) {
            const float* src = row < 256 ? a.in[1] + (size_t)(row - ROW0) * DM : a.in[0] + (size_t)(row - 256) * DM;
#pragma unroll
            for (int j = 0; j < 8; ++j) h[j] = __builtin_nontemporal_load((const f32x4*)(src + 4 * lane + 256 * j));
        } else {
            f32x4 o[8]; float ss = 0.f;
#pragma unroll
            for (int j = 0; j < 8; ++j) { o[j] = *(const f32x4*)(OUT + (size_t)row * DM + 4 * lane + 256 * j); ss += o[j].x * o[j].x + o[j].y * o[j].y + o[j].z * o[j].z + o[j].w * o[j].w; }
            const float rstd = rsqrtf(wave_sum(ss) * (1.f / DM) + EPS);
#pragma unroll
            for (int j = 0; j < 8; ++j) { const f32x4 pw = *(const f32x4*)(postw + 4 * lane + 256 * j); h[j] = *(const f32x4*)(H + (size_t)row * DM + 4 * lane + 256 * j) + o[j] * rstd * pw; }
        }
        if (mode == 2) {
#pragma unroll
            for (int j = 0; j < 8; ++j) *(f32x4*)(a.out + (size_t)(row - 256) * DM + 4 * lane + 256 * j) = h[j];
            continue;
        }
        float ss = 0.f;
#pragma unroll
        for (int j = 0; j < 8; ++j) { *(f32x4*)(H + (size_t)row * DM + 4 * lane + 256 * j) = h[j]; ss += h[j].x * h[j].x + h[j].y * h[j].y + h[j].z * h[j].z + h[j].w * h[j].w; }
        const float rstd = rsqrtf(wave_sum(ss) * (1.f / DM) + EPS);
#pragma unroll
        for (int j = 0; j < 8; ++j) { const f32x4 pw = *(const f32x4*)(prew + 4 * lane + 256 * j); const f32x4 u = h[j] * rstd * pw;
            *(u32x2*)(U + (size_t)row * DM + 4 * lane + 256 * j) = (u32x2){cvt_pk_bf16(u.x, u.y), cvt_pk_bf16(u.z, u.w)}; }
    }
}

FI void conv8(const bf16_t* XBC, const float* cw, const float* cbias, int R, int col, float* o) {
    if (R < ROW0) {
#pragma unroll
        for (int e = 0; e < 8; ++e) o[e] = 0.f;
        return;
    }
    const f32x4 b0 = *(const f32x4*)(cbias + col), b1 = *(const f32x4*)(cbias + col + 4);
#pragma unroll
    for (int e = 0; e < 4; ++e) { o[e] = b0[e]; o[4 + e] = b1[e]; }
#pragma unroll
    for (int i = 0; i < 4; ++i) {
        float x[8]; unpack8(*(const u32x4*)(XBC + (size_t)(R - 3 + i) * 3072 + col), x);
        const f32x4 w0 = *(const f32x4*)(cw + i * 3072 + col), w1 = *(const f32x4*)(cw + i * 3072 + col + 4);
#pragma unroll
        for (int e = 0; e < 4; ++e) { o[e] += x[e] * w0[e]; o[4 + e] += x[4 + e] * w1[e]; }
    }
#pragma unroll
    for (int e = 0; e < 8; ++e) o[e] = silu_f(o[e]);
}
constexpr int LDP = 136;
FI bf16x8 ldsfrag(const bf16_t* base, int row0, int kk, int lane) { return *(const bf16x8*)(base + (row0 + (lane & 31)) * LDP + kk * 16 + 8 * (lane >> 5)); }

FI void ssd_s1(const Args& a, int layer, int c, int g, unsigned char* lds) {
    const int tid = tid_l(), lane = tid & 63, w = tid >> 6;
    const int r0 = 128 + 128 * c;
    bf16_t* cmS = (bf16_t*)lds; bf16_t* bmS = cmS + 128 * LDP; bf16_t* bmT = bmS + 128 * LDP;
    bf16_t* G = cmS; bf16_t* xdtT = bmS; bf16_t* xdtdT = bmS + 64 * LDP;
    float* csS = (float*)(lds + 104448); float* dtS = csS + 1024;
    const bf16_t* XBC = (const bf16_t*)(a.ws + OFF_XBC);
    const float* cw = a.in[7] + (size_t)layer * 4 * 3072; const float* cbias = a.in[8] + (size_t)layer * 3072;
    const float* DT = (const float*)(a.ws + OFF_DT);
    bf16_t* CM = (bf16_t*)(a.ws + OFF_CM); bf16_t* XS = (bf16_t*)(a.ws + OFF_XS);
    float* CSB = (float*)(a.ws + OFF_CSB); bf16_t* YD = (bf16_t*)(a.ws + OFF_YD); float* ST = (float*)(a.ws + OFF_ST); float* CD = (float*)(a.ws + OFF_CD);
#pragma unroll 4
    for (int it = tid; it < 4096; it += 512) {
        const int mat = it >> 11, row = (it >> 4) & 127, cg8 = it & 15;
        const int col = 2048 + mat * 512 + g * 128 + cg8 * 8, R = r0 + row;
        float o[8]; conv8(XBC, cw, cbias, R, col, o);
        const u32x4 pk = pack8(o);
        if (mat == 0) {
            *(u32x4*)(bmS + row * LDP + cg8 * 8) = pk;
#pragma unroll
            for (int e = 0; e < 8; ++e) bmT[(cg8 * 8 + e) * LDP + row] = f2bf(o[e]);
        } else {
            *(u32x4*)(cmS + row * LDP + cg8 * 8) = pk;
            *(u32x4*)(CM + (size_t)R * 512 + g * 128 + cg8 * 8) = pk;
        }
    }
    __syncthreads();
    f32x16 cb[2];
#pragma unroll
    for (int i = 0; i < 16; ++i) { cb[0][i] = 0.f; cb[1][i] = 0.f; }
    const int m0 = 32 * (w >> 1);
    {
        const int n0 = 64 * (w & 1);
#pragma unroll
        for (int kk = 0; kk < 8; ++kk) { const bf16x8 av = ldsfrag(cmS, m0, kk, lane);
            cb[0] = mfma32(av, ldsfrag(bmS, n0, kk, lane), cb[0]); cb[1] = mfma32(av, ldsfrag(bmS, n0 + 32, kk, lane), cb[1]); }
    }
    {
        const int h = 8 * g + w; const float ah = -__expf(a.in[10][layer * 32 + h]);
        const float d0 = DT[(r0 + 2 * lane) * 32 + h], d1 = DT[(r0 + 2 * lane + 1) * 32 + h];
        const float a0 = d0 * ah, a1 = d1 * ah; float s = a0 + a1;
#pragma unroll
        for (int o = 1; o < 64; o <<= 1) { const float t = __shfl_up(s, o); if (lane >= o) s += t; }
        csS[w * 128 + 2 * lane] = s - a1; csS[w * 128 + 2 * lane + 1] = s; dtS[w * 128 + 2 * lane] = d0; dtS[w * 128 + 2 * lane + 1] = d1;
        CSB[(r0 + 2 * lane) * 32 + h] = s - a1; CSB[(r0 + 2 * lane + 1) * 32 + h] = s;
        if (lane == 63) CD[c * 32 + h] = __expf(s);
    }
    __syncthreads();
#pragma unroll 1
    for (int r = 0; r < 8; ++r) {
        const int h = 8 * g + r;
        {
            int ln = lane; asm volatile("" : "+v"(ln));
            const int n0 = 64 * (w & 1);
#pragma unroll
            for (int t = 0; t < 2; ++t)
#pragma unroll
                for (int i = 0; i < 16; ++i) { const int l = m0 + (i & 3) + 8 * (i >> 2) + 4 * (ln >> 5), s = n0 + 32 * t + (ln & 31);
                    const int msk = (s - l - 1) >> 31;
                    const float v = __uint_as_float(__float_as_uint(cb[t][i] * __expf(fminf(csS[r * 128 + l] - csS[r * 128 + s], 0.f))) & (unsigned)msk);
                    G[l * LDP + s] = f2bf(v); if ((i & 3) == 3) __builtin_amdgcn_sched_barrier(0); }
        }
#pragma unroll 2
        for (int it = tid; it < 1024; it += 512) {
            const int row = it >> 3, pg = it & 7, R = r0 + row, col = h * 64 + pg * 8;
            float o[8]; conv8(XBC, cw, cbias, R, col, o);
            __builtin_nontemporal_store(pack8(o), (u32x4*)(XS + (size_t)R * 2048 + col));
            const float dtv = dtS[r * 128 + row], dec = __expf(csS[r * 128 + 127] - csS[r * 128 + row]);
#pragma unroll
            for (int e = 0; e < 8; ++e) { const float xd = o[e] * dtv; xdtT[(pg * 8 + e) * LDP + row] = f2bf(xd); xdtdT[(pg * 8 + e) * LDP + row] = f2bf(xd * dec); }
        }
        __syncthreads();
        {
            const int n0 = 32 * (w & 1); f32x16 acc;
#pragma unroll
            for (int i = 0; i < 16; ++i) acc[i] = 0.f;
#pragma unroll
            for (int kk = 0; kk < 8; ++kk) acc = mfma32(ldsfrag(G, m0, kk, lane), ldsfrag(xdtT, n0, kk, lane), acc);
#pragma unroll
            for (int i = 0; i < 16; ++i) { const int l = m0 + (i & 3) + 8 * (i >> 2) + 4 * (lane >> 5); __builtin_nontemporal_store(f2bf(acc[i]), &YD[(size_t)(r0 + l) * 2048 + h * 64 + n0 + (lane & 31)]); }
        }
        {
            const int p0 = 32 * (w >> 2), n0 = 32 * (w & 3); f32x16 acc;
#pragma unroll
            for (int i = 0; i < 16; ++i) acc[i] = 0.f;
#pragma unroll
            for (int kk = 0; kk < 8; ++kk) acc = mfma32(ldsfrag(xdtdT, p0, kk, lane), ldsfrag(bmT, n0, kk, lane), acc);
#pragma unroll
            for (int i = 0; i < 16; ++i) { const int pp = p0 + (i & 3) + 8 * (i >> 2) + 4 * (lane >> 5); __builtin_nontemporal_store(acc[i], &ST[((size_t)(c * 32 + h) * 64 + pp) * 128 + n0 + (lane & 31)]); }
        }
        __syncthreads();
    }
}

FI void ssd_scan_item(const Args& a, int item) {
    const int q = item * 512 + tid_l();
    const int h = q >> 11;
    const f32x4* base = (const f32x4*)(a.ws + OFF_ST) + q; const float* CD = (const float*)(a.ws + OFF_CD);
    u32x2* hs = (u32x2*)(a.ws + OFF_HS) + q;
    f32x4 state = (f32x4){0.f, 0.f, 0.f, 0.f};
#pragma unroll 1
    for (int c0 = 0; c0 < NCH; c0 += 13) {
        f32x4 v[13]; float cd[13];
#pragma unroll
        for (int j = 0; j < 13; ++j) { v[j] = __builtin_nontemporal_load(&base[(size_t)(c0 + j) * 65536]); cd[j] = CD[(c0 + j) * 32 + h]; }
#pragma unroll
        for (int j = 0; j < 13; ++j) { hs[(size_t)(c0 + j) * 65536] = (u32x2){cvt_pk_bf16(state.x, state.y), cvt_pk_bf16(state.z, state.w)}; state = state * cd[j] + v[j]; }
    }
}

FI void ssd_s3(const Args& a, int layer, int c, int g, unsigned char* lds) {
    const int tid = tid_l(), lane = tid & 63, w = tid >> 6;
    const int r0 = 128 + 128 * c;
    bf16_t* cmS = (bf16_t*)lds; bf16_t* Hs = cmS + 128 * LDP; float* rowss = (float*)(lds + 53248);
    const bf16_t* CM = (const bf16_t*)(a.ws + OFF_CM); const bf16_t* XS = (const bf16_t*)(a.ws + OFF_XS); const bf16_t* ZS = (const bf16_t*)(a.ws + OFF_ZS);
    const float* CSB = (const float*)(a.ws + OFF_CSB); const bf16_t* YD = (const bf16_t*)(a.ws + OFF_YD); const float* ST = (const float*)(a.ws + OFF_ST);
    bf16_t* MIX = (bf16_t*)(a.ws + OFF_MIX);
    const float* dskip = a.in[11] + layer * 32; const float* normw = a.in[12] + (size_t)layer * 2048;
    {
        u32x4 t[4];
#pragma unroll
        for (int j = 0; j < 4; ++j) { const int it = tid + 512 * j, row = it >> 4, cg8 = it & 15; t[j] = *(const u32x4*)(CM + (size_t)(r0 + row) * 512 + g * 128 + cg8 * 8); }
#pragma unroll
        for (int j = 0; j < 4; ++j) { const int it = tid + 512 * j, row = it >> 4, cg8 = it & 15; *(u32x4*)(cmS + row * LDP + cg8 * 8) = t[j]; }
    }
    if (tid < 128) rowss[tid] = 0.f;
    const int pt = w & 1, lt = w >> 1;
    const int l = lt * 32 + (lane & 31), R = r0 + l;
    const bf16_t* HSB = (const bf16_t*)(a.ws + OFF_HS);
    u32x4 hreg[2];
    {
        const bf16_t* src = HSB + ((size_t)(c * 32 + 8 * g) * 64) * 128;
#pragma unroll
        for (int j = 0; j < 2; ++j) { const int it = tid + 512 * j; hreg[j] = *(const u32x4*)(src + (size_t)(it >> 4) * 128 + (it & 15) * 8); }
    }
    float ss = 0.f;
#pragma unroll 1
    for (int r = 0; r < 8; ++r) {
        const int h = 8 * g + r;
        __syncthreads();
#pragma unroll
        for (int j = 0; j < 2; ++j) { const int it = tid + 512 * j; *(u32x4*)(Hs + (it >> 4) * LDP + (it & 15) * 8) = hreg[j]; }
        __syncthreads();
        if (r < 7) {
            const bf16_t* src = HSB + ((size_t)(c * 32 + h + 1) * 64) * 128;
#pragma unroll
            for (int j = 0; j < 2; ++j) { const int it = tid + 512 * j; hreg[j] = *(const u32x4*)(src + (size_t)(it >> 4) * 128 + (it & 15) * 8); }
        }
        const int colb = h * 64 + pt * 32 + 4 * (lane >> 5);
        f32x4 yd[4]; u32x2 xs[4], zs[4];
#pragma unroll
        for (int q = 0; q < 4; ++q) { const size_t o = (size_t)R * 2048 + colb + 8 * q; { const u32x2 yr = *(const u32x2*)(YD + o); yd[q] = (f32x4){bflo(yr.x), bfhi(yr.x), bflo(yr.y), bfhi(yr.y)}; } xs[q] = *(const u32x2*)(XS + o); zs[q] = *(const u32x2*)(ZS + o); }
        const float ecs = __expf(CSB[R * 32 + h]), dsk = dskip[h];
        f32x16 acc;
#pragma unroll
        for (int i = 0; i < 16; ++i) acc[i] = 0.f;
#pragma unroll
        for (int kk = 0; kk < 8; ++kk) acc = mfma32(ldsfrag(Hs, pt * 32, kk, lane), ldsfrag(cmS, lt * 32, kk, lane), acc);
#pragma unroll
        for (int q = 0; q < 4; ++q) {
            const float y0 = (yd[q].x + acc[4 * q] * ecs + dsk * bflo(xs[q].x)) * bflo(zs[q].x);
            const float y1 = (yd[q].y + acc[4 * q + 1] * ecs + dsk * bfhi(xs[q].x)) * bfhi(zs[q].x);
            const float y2 = (yd[q].z + acc[4 * q + 2] * ecs + dsk * bflo(xs[q].y)) * bflo(zs[q].y);
            const float y3 = (yd[q].w + acc[4 * q + 3] * ecs + dsk * bfhi(xs[q].y)) * bfhi(zs[q].y);
            const unsigned w0 = cvt_pk_bf16(y0, y1), w1 = cvt_pk_bf16(y2, y3);
            const float b0 = bflo(w0), b1 = bfhi(w0), b2 = bflo(w1), b3 = bfhi(w1);
            ss += b0 * b0 + b1 * b1 + b2 * b2 + b3 * b3;
            *(u32x2*)(MIX + (size_t)R * DMIX + 1024 + colb + 8 * q) = (u32x2){w0, w1};
        }
    }
    ss += __shfl_xor(ss, 32);
    if (lane < 32) atomicAdd(&rowss[l], ss);
    __threadfence();
    __syncthreads();
#pragma unroll 1
    for (int l2 = w * 16; l2 < w * 16 + 16; l2 += 4) {
        u32x4 t[4];
#pragma unroll
        for (int j = 0; j < 4; ++j) t[j] = *(const u32x4*)(MIX + (size_t)(r0 + l2 + j) * DMIX + 1024 + g * 512 + lane * 8);
        const f32x4 n0v = *(const f32x4*)(normw + g * 512 + lane * 8), n1v = *(const f32x4*)(normw + g * 512 + lane * 8 + 4);
#pragma unroll
        for (int j = 0; j < 4; ++j) {
            float v[8]; unpack8(t[j], v);
            const float rstd = rsqrtf(rowss[l2 + j] * (1.f / 512.f) + EPS);
#pragma unroll
            for (int e = 0; e < 4; ++e) { v[e] *= rstd * n0v[e]; v[4 + e] *= rstd * n1v[e]; }
            *(u32x4*)(MIX + (size_t)(r0 + l2 + j) * DMIX + 1024 + g * 512 + lane * 8) = pack8(v);
        }
    }
}

FI void pool_pre_item(const Args& a, int item) {
    const bf16_t* PV = (const bf16_t*)(a.ws + OFF_PV); bf16_t* PA = (bf16_t*)(a.ws + OFF_U);
    const int q = tid_l();
    const int col = (q & 127) * 8, grp = col >> 8, r0 = item * 32 + (q >> 7) * 8, wdw = 2 << grp;
    u32x4 raw[23];
#pragma unroll
    for (int j = 0; j < 23; ++j) { const int rr = r0 - 15 + j; raw[j] = *(const u32x4*)(PV + (size_t)(rr < 0 ? 0 : rr) * 1024 + col); }
#pragma unroll
    for (int i = 0; i < 8; ++i) {
        const int row = r0 + i, t = row - ROW0;
        float y[8];
#pragma unroll
        for (int e = 0; e < 8; ++e) y[e] = 0.f;
        if (t >= 0) {
            float v0[8]; unpack8(raw[15 + i], v0);
            float sacc[8];
#pragma unroll
            for (int e = 0; e < 8; ++e) sacc[e] = v0[e];
#pragma unroll
            for (int j = 1; j < 16; ++j) { float x[8]; unpack8(raw[15 + i - j], x); const float m = j < wdw ? 1.f : 0.f;
#pragma unroll
                for (int e = 0; e < 8; ++e) sacc[e] += m * x[e]; }
            const float ic = 1.f / (float)min(wdw, t + 1);
#pragma unroll
            for (int e = 0; e < 8; ++e) y[e] = sacc[e] * ic - v0[e];
        }
        *(u32x4*)(PA + ((size_t)grp * MR + row) * 256 + (col & 255)) = pack8(y);
    }
}

constexpr int IDX_BLOCK_TASKS = 1188;
template <int MODE>
FI void indexer_block_task(const Args& a, int id, unsigned char* lds) {
    const int tid = tid_l(), lane = tid & 63, w = tid >> 6;
    int m = 65, rem = id;
    for (;;) { const int c = 4 * ((m + 7) >> 3); if (rem < c) break; rem -= c; --m; }
    const int per = (m + 7) >> 3, r = rem / per, j = rem - r * per;
    const int qg = 4 * m + r, qrow0 = 32 * qg, qb = qrow0 >> 8;
    const bf16_t* IQ = (const bf16_t*)(a.ws + OFF_IQ); const bf16_t* IK = (const bf16_t*)(a.ws + OFF_IK); const float* IW = (const float*)(a.ws + OFF_IW);
    LAS bf16_t* qs = (LAS bf16_t*)((LAS unsigned char*)lds);
    {
        const int row = tid >> 4, c = tid & 15;
        const bf16_t* src = IQ + (size_t)(qrow0 + row) * 1024 + c * 64;
        u32x4 t[8];
#pragma unroll
        for (int e = 0; e < 8; ++e) t[e] = *(const u32x4*)(src + 8 * e);
#pragma unroll
        for (int e = 0; e < 8; ++e) *(LAS u32x4*)(qs + row * 1032 + c * 64 + 8 * e) = t[e];
    }
    const int kt = 8 * j + 1 + w;
    bf16x8 ka[4][4];
    if (kt <= m) {
#pragma unroll
        for (int mt = 0; mt < 4; ++mt)
#pragma unroll
            for (int kk = 0; kk < 4; ++kk) ka[mt][kk] = *(const bf16x8*)(IK + (size_t)(128 * kt + 32 * mt + (lane & 31)) * 64 + kk * 16 + 8 * (lane >> 5));
    }
    __syncthreads();
    if (kt > m) return;
    f32x16 acc[4];
#pragma unroll
    for (int mt = 0; mt < 4; ++mt)
#pragma unroll
        for (int i = 0; i < 16; ++i) acc[mt][i] = 0.f;
    const float* wp = IW + (size_t)(qrow0 + (lane & 31)) * 16;
    const LAS bf16_t* qfr = qs + (lane & 31) * 1032 + 8 * (lane >> 5);
#define IDX_CHAIN(dst, mt, qq) do { _Pragma("unroll") for (int i = 0; i < 16; ++i) dst[i] = 0.f; _Pragma("unroll") for (int kk = 0; kk < 4; ++kk) dst = mfma32(ka[mt][kk], qq[kk], dst); } while (0)
#define IDX_ACC(src, mt, wv) do { } while (0)
#define IDX_STEP(dstC, mtC, qq, srcA, mtA, wv) do { _Pragma("unroll") for (int kk = 0; kk < 4; ++kk) { \
        if (kk == 0) { _Pragma("unroll") for (int i = 0; i < 16; ++i) dstC[i] = 0.f; } \
        dstC = mfma32(ka[mtC][kk], qq[kk], dstC); __builtin_amdgcn_sched_barrier(0); \
        _Pragma("unroll") for (int i = 0; i < 4; ++i) acc[mtA][4 * kk + i] += wv * __int_as_float(max(__float_as_int(srcA[4 * kk + i]), 0)); \
        __builtin_amdgcn_sched_barrier(0); } } while (0)
    bf16x8 qv[4], qx[4]; f32x16 sA, sB;
    float wh = wp[0];
#pragma unroll
    for (int kk = 0; kk < 4; ++kk) qv[kk] = *(const LAS bf16x8*)(qfr + kk * 16);
    IDX_CHAIN(sA, 0, qv);
#pragma unroll 1
    for (int h = 0; h < 16; ++h) {
        const int hn = h < 15 ? h + 1 : 15;
        const float wnx = wp[hn];
#pragma unroll
        for (int kk = 0; kk < 4; ++kk) qx[kk] = *(const LAS bf16x8*)(qfr + hn * 64 + kk * 16);
        IDX_STEP(sB, 1, qv, sA, 0, wh);
        IDX_STEP(sA, 2, qv, sB, 1, wh);
        IDX_STEP(sB, 3, qv, sA, 2, wh);
        IDX_STEP(sA, 0, qx, sB, 3, wh);
#pragma unroll
        for (int kk = 0; kk < 4; ++kk) qv[kk] = qx[kk];
        wh = wnx;
    }
#undef IDX_STEP
#undef IDX_CHAIN
#undef IDX_ACC
    int ln2 = lane; asm volatile("" : "+v"(ln2));
    float* dst = (float*)(a.ws + OFF_SC) + (size_t)(qb * qb + kt - 1) * 32768 + (size_t)((qrow0 & 255) + (ln2 & 31)) * 128 + 4 * (ln2 >> 5);
#pragma unroll
    for (int mt = 0; mt < 4; ++mt)
#pragma unroll
        for (int i4 = 0; i4 < 4; ++i4) { if (MODE == 0 || acc[mt][4 * i4] == 12345.678f) __builtin_nontemporal_store((f32x4){acc[mt][4 * i4], acc[mt][4 * i4 + 1], acc[mt][4 * i4 + 2], acc[mt][4 * i4 + 3]}, (f32x4*)(dst + 32 * mt + 8 * i4)); }
}

template <int N, int STRIDE>
FI unsigned bisect_keys(const unsigned (&key)[N], int target, bool& exact) {
    unsigned prefix = 0u; exact = false;
#pragma unroll 1
    for (int bit = 31; bit >= 0; --bit) {
        const unsigned cand = prefix | (1u << bit);
        int cnt = 0;
#pragma unroll
        for (int i = 0; i < N; i += STRIDE) { cnt += __popcll(__ballot(key[i] >= cand)); if (((i / STRIDE) & 7) == 7) __builtin_amdgcn_sched_barrier(0); }
        if (cnt >= target) { prefix = cand; if (cnt == target) { exact = true; break; } }
    }
    return prefix;
}
template <int NJ>
FI void topk_row(const Args& a, int rq, int lane, unsigned* cand_k, int* cand_i) {
    const int qb = rq >> 8;
    const float* SC = (const float*)(a.ws + OFF_SC);
    int* IDX = (int*)(a.ws + OFF_IDX) + (size_t)rq * 256; int* CNT = (int*)(a.ws + OFF_CNT);
    unsigned key[NJ * 4];
    {
        const float* rowp = SC + (size_t)(qb * qb) * 32768 + (size_t)(rq & 255) * 128 + 4 * (lane & 31) + (size_t)(lane >> 5) * 32768;
        const int ktmax = 2 * qb + 1 - (lane >> 5);
#pragma unroll
        for (int j = 0; j < NJ; ++j) {
            const int jj = (1 + 2 * j <= ktmax) ? j : 0;
            const u32x4 v = __builtin_nontemporal_load((const u32x4*)(rowp + (size_t)jj * 65536));
            key[4 * j] = v.x; key[4 * j + 1] = v.y; key[4 * j + 2] = v.z; key[4 * j + 3] = v.w;
        }
        __builtin_amdgcn_sched_barrier(0);
#pragma unroll
        for (int j = 0; j < NJ; ++j) {
            const int k0 = 128 * (1 + 2 * j + (lane >> 5)) + 4 * (lane & 31);
#pragma unroll
            for (int e = 0; e < 4; ++e) { const unsigned u = key[4 * j + e]; const unsigned m = (u & 0x80000000u) ? ~u : (u | 0x80000000u);
                const int kr = k0 + e; key[4 * j + e] = (kr >= ROW0 && kr <= rq) ? m : 0u; }
            if ((j & 3) == 3) __builtin_amdgcn_sched_barrier(0);
        }
    }
    const int n = rq - ROW0 + 1, want = n < 256 ? n : 256;
    int ln2 = lane; asm volatile("" : "+v"(ln2));
    const unsigned long long ltmask = (1ull << ln2) - 1ull;
    const int kbase = 128 * (1 + (ln2 >> 5)) + 4 * (ln2 & 31);
    bool done = false;
    if (n > 256) {
        bool ex; unsigned Ts = bisect_keys<NJ * 4, 8>(key, 48, ex);
        if (Ts == 0u) Ts = 1u;
        Ts = (unsigned)__builtin_amdgcn_readfirstlane((int)Ts);
        int c = 0;
#pragma unroll
        for (int i = 0; i < NJ * 4; ++i) { c += __popcll(__ballot(key[i] >= Ts)); if ((i & 7) == 7) __builtin_amdgcn_sched_barrier(0); }
        if (c >= 256 && c <= 512) {
            asm volatile("" : "+s"(Ts));
            int base = 0;
#pragma unroll
            for (int i = 0; i < NJ * 4; ++i) {
                const bool pr = key[i] >= Ts; const unsigned long long mk = __ballot(pr);
                if (pr) { const int pos = base + __popcll(mk & ltmask); cand_k[pos] = key[i]; cand_i[pos] = kbase + 256 * (i >> 2) + (i & 3); }
                base += __popcll(mk);
                if ((i & 3) == 3) __builtin_amdgcn_sched_barrier(0);
            }
            asm volatile("s_waitcnt lgkmcnt(0)" ::: "memory");
            unsigned ck[8]; int ci[8];
#pragma unroll
            for (int r = 0; r < 8; ++r) { const int p = ln2 + 64 * r; ck[r] = p < c ? cand_k[p] : 0u; ci[r] = p < c ? cand_i[p] : 0; }
            bool exact; const unsigned pre = bisect_keys<8, 1>(ck, 256, exact);
            const unsigned P = exact ? pre - 1u : pre;
            int ob = 0;
#pragma unroll
            for (int r = 0; r < 8; ++r) { const bool pr = ck[r] > P; const unsigned long long mk = __ballot(pr);
                if (pr) IDX[ob + __popcll(mk & ltmask)] = ci[r];
                ob += __popcll(mk); }
            if (ob < 256) {
#pragma unroll
                for (int r = 0; r < 8; ++r) { const bool pr = ck[r] == P; const unsigned long long mk = __ballot(pr);
                    const int pos = ob + __popcll(mk & ltmask);
                    if (pr && pos < 256) IDX[pos] = ci[r];
                    ob += __popcll(mk); }
            }
            done = true;
        }
    }
    if (!done) {
        unsigned P = 0u;
        if (n > 256) { bool exact; const unsigned pre = bisect_keys<NJ * 4, 1>(key, 256, exact); P = exact ? pre - 1u : pre; }
        int base = 0;
#pragma unroll
        for (int i = 0; i < NJ * 4; ++i) {
            const bool pr = key[i] > P; const unsigned long long mk = __ballot(pr);
            if (pr) IDX[base + __popcll(mk & ltmask)] = kbase + 256 * (i >> 2) + (i & 3);
            base += __popcll(mk);
            if ((i & 3) == 3) __builtin_amdgcn_sched_barrier(0);
        }
        if (base < want) {
#pragma unroll
            for (int i = 0; i < NJ * 4; ++i) {
                const bool pr = key[i] == P; const unsigned long long mk = __ballot(pr);
                const int pos = base + __popcll(mk & ltmask);
                if (pr && pos < want) IDX[pos] = kbase + 256 * (i >> 2) + (i & 3);
                base += __popcll(mk);
                if ((i & 3) == 3) __builtin_amdgcn_sched_barrier(0);
            }
        }
    }
    if (lane == 0) CNT[rq] = want;
}
FI void topk_item(const Args& a, int item, unsigned char* lds) {
    const int tid = tid_l(), lane = tid & 63, w = tid >> 6;
    const int rq = MR - 1 - item;
    if (rq < ROW0) return;
    unsigned* ck = (unsigned*)(lds + w * 4096); int* ci = (int*)(lds + w * 4096 + 2048);
    const int qb = rq >> 8;
    if (qb < 8) topk_row<8>(a, rq, lane, ck, ci);
    else if (qb < 16) topk_row<16>(a, rq, lane, ck, ci);
    else if (qb < 24) topk_row<24>(a, rq, lane, ck, ci);
    else topk_row<33>(a, rq, lane, ck, ci);
}

template <int ATTV>
FI void attn_item(const Args& a, int item, unsigned char* lds) {
    const int tid = tid_l(), lane = tid & 63, w = tid >> 6;
    const int rq = ROW0 + (item >> 1), g = item & 1;
    LAS unsigned char* sl = (LAS unsigned char*)lds + w * 16384;
    LAS float* Pw = (LAS float*)sl; LAS int* Iw = (LAS int*)(sl + 4096);
    LAS bf16_t* Pb = (LAS bf16_t*)(sl + 5120);
    LAS bf16_t* Vs = (LAS bf16_t*)(sl + 7168);
    const bf16_t* Q = (const bf16_t*)(a.ws + OFF_Q); const bf16_t* K = (const bf16_t*)(a.ws + OFF_K); const bf16_t* V = (const bf16_t*)(a.ws + OFF_V);
    const bf16_t* AG = (const bf16_t*)(a.ws + OFF_AG); bf16_t* MIX = (bf16_t*)(a.ws + OFF_MIX);
    const int* IDX = (const int*)(a.ws + OFF_IDX) + (size_t)rq * 256;
    const int cnt = ((const int*)(a.ws + OFF_CNT))[rq];
#pragma unroll
    for (int i = 0; i < 4; ++i) { const int k = lane + 64 * i; Iw[k] = k < cnt ? IDX[k] : rq; }
    asm volatile("s_waitcnt lgkmcnt(0)" ::: "memory");
    const int hq = lane & 15, quad = lane >> 4;
    bf16x8 bq[4];
#pragma unroll
    for (int kk = 0; kk < 4; ++kk) { bq[kk] = (bf16x8){0, 0, 0, 0, 0, 0, 0, 0};
        if (hq < 4) bq[kk] = *(const bf16x8*)(Q + (size_t)rq * 1024 + (4 * g + hq) * 128 + kk * 32 + 8 * quad); }
    const float scale = 0.08838834764831845f;
    const bf16_t* kbase = K + g * 128 + 8 * quad;
    LAS float* pwl = Pw + 16 * quad + hq; asm volatile("" : "+v"(pwl));
    const LAS int* iwl = Iw + hq; asm volatile("" : "+v"(iwl));
    LAS float* pws = Pw + 4 * (lane >> 2) + (lane & 3); asm volatile("" : "+v"(pws));
    {
        bf16x8 kA[4][4], kB[4][4];
#define ATT_LOADK(dst, tg) do { _Pragma("unroll") for (int t = 0; t < 4; ++t) { const bf16_t* kp = kbase + (size_t)iwl[(tg) * 64 + t * 16] * 256; \
            _Pragma("unroll") for (int kk = 0; kk < 4; ++kk) dst[t][kk] = *(const bf16x8*)(kp + kk * 32); } } while (0)
#define ATT_QK(src, tg) do { _Pragma("unroll") for (int t = 0; t < 4; ++t) { f32x4 sc4 = (f32x4){0.f, 0.f, 0.f, 0.f}; \
            _Pragma("unroll") for (int kk = 0; kk < 4; ++kk) sc4 = mfma16(src[t][kk], bq[kk], sc4); \
            if (hq < 4) { _Pragma("unroll") for (int i = 0; i < 4; ++i) { const int key = ((tg) * 4 + t) * 16 + 4 * quad + i; pwl[(((tg) * 4 + t) * 16 + i) * 4] = (key < cnt) ? sc4[i] * scale : -INFINITY; } } } } while (0)
        ATT_LOADK(kA, 0);
        ATT_LOADK(kB, 1); ATT_QK(kA, 0); __builtin_amdgcn_sched_barrier(0);
        ATT_LOADK(kA, 2); ATT_QK(kB, 1); __builtin_amdgcn_sched_barrier(0);
        ATT_LOADK(kB, 3); ATT_QK(kA, 2); __builtin_amdgcn_sched_barrier(0);
        ATT_QK(kB, 3);
#undef ATT_LOADK
#undef ATT_QK
    }
    const bf16_t* vb = V + g * 128 + 8 * hq;
    u32x4 vr[4][8];
#define ATT_LOADV(c) do { _Pragma("unroll") for (int j = 0; j < 8; ++j) { const int kr = Iw[(c) * 32 + 4 * j + quad]; vr[(c) & 3][j] = *(const u32x4*)(vb + (size_t)kr * 256); } } while (0)
    ATT_LOADV(0); ATT_LOADV(1); ATT_LOADV(2);
    asm volatile("s_waitcnt lgkmcnt(0)" ::: "memory");
    float sum = 0.f;
    {
        float lg[16]; float mx = -INFINITY;
#pragma unroll
        for (int m = 0; m < 16; ++m) { lg[m] = pws[64 * m]; mx = fmaxf(mx, lg[m]); }
        mx = fmaxf(mx, __shfl_xor(mx, 4)); mx = fmaxf(mx, __shfl_xor(mx, 8)); mx = fmaxf(mx, __shfl_xor(mx, 16)); mx = fmaxf(mx, __shfl_xor(mx, 32));
        LAS bf16_t* pbs = Pb + (lane & 3) * 256 + (lane >> 2);
#pragma unroll
        for (int m = 0; m < 16; ++m) { const float p = __expf(lg[m] - mx); const bf16_t pb = f2bf(p); sum += bf2f(pb); pbs[16 * m] = pb; }
        sum += __shfl_xor(sum, 4); sum += __shfl_xor(sum, 8); sum += __shfl_xor(sum, 16); sum += __shfl_xor(sum, 32);
    }
    asm volatile("s_waitcnt lgkmcnt(0)" ::: "memory");
    f32x4 acc[8];
#pragma unroll
    for (int t = 0; t < 8; ++t) acc[t] = (f32x4){0.f, 0.f, 0.f, 0.f};
    const LAS bf16_t* pa_p = Pb + (lane & 3) * 256 + 8 * quad;
    const LAS bf16_t* vrd = Vs + (8 * quad) * 136 + hq;
    LAS bf16_t* vwr = Vs + quad * 136 + 8 * hq;
#pragma unroll
    for (int c = 0; c < 8; ++c) {
        asm volatile("" ::: "memory");
#pragma unroll
        for (int j = 0; j < 8; ++j) *(LAS u32x4*)(vwr + (4 * j) * 136) = vr[c & 3][j];
        asm volatile("" ::: "memory");
        if (c + 3 < 8) ATT_LOADV(c + 3);
        __builtin_amdgcn_sched_barrier(0);
        const bf16x8 pa = *(const LAS bf16x8*)(pa_p + c * 32);
#pragma unroll
        for (int t = 0; t < 8; ++t) {
            bf16x8 bv;
#pragma unroll
            for (int j = 0; j < 8; ++j) bv[j] = (short)vrd[j * 136 + 16 * t];
            acc[t] = mfma16(pa, bv, acc[t]);
        }
    }
#undef ATT_LOADV
    asm volatile("s_waitcnt lgkmcnt(0)" ::: "memory");
    if (quad == 0) {
#pragma unroll
        for (int t = 0; t < 8; ++t)
#pragma unroll
            for (int i = 0; i < 4; ++i) Pw[i * 128 + 16 * t + hq] = acc[t][i];
    }
    asm volatile("s_waitcnt lgkmcnt(0)" ::: "memory");
    const float isum = 1.f / __shfl(sum, quad);
    int ln3 = lane; asm volatile("" : "+v"(ln3));
    const int hd = ln3 >> 4, d0 = 8 * (ln3 & 15);
    const f32x4 o0 = *(const LAS f32x4*)(Pw + hd * 128 + d0), o1 = *(const LAS f32x4*)(Pw + hd * 128 + d0 + 4);
    float r[8] = {o0.x, o0.y, o0.z, o0.w, o1.x, o1.y, o1.z, o1.w};
    const int col = (4 * g + hd) * 128 + d0;
    float gt[8]; unpack8(*(const u32x4*)(AG + (size_t)rq * 1024 + col), gt);
#pragma unroll
    for (int e = 0; e < 8; ++e) r[e] *= isum * gt[e];
    if (ATTV == 0 || r[0] == 12345.678f) *(u32x4*)(MIX + (size_t)rq * DMIX + 3072 + col) = pack8(r);
}

#define XB_TMO      128
#define XB_XCNT(j)  (256  + 64 * (j))
#define XB_XSUB(j)  (1280 + 64 * (j))
#define XB_XGEN(j)  (2304 + 64 * (j))
#define XB_TOP      3328
#define XB_TOPGEN   3392
#define XCD_BAR_WORDS 3456
#define XB_SPIN_CAP (1u << 20)
static_assert(OFF_BAR + XCD_BAR_WORDS * 4 <= CTL_BYTES, "barrier words inside the memset region");
FI unsigned xb_ld(unsigned* p)              { return __hip_atomic_load(p, __ATOMIC_RELAXED, __HIP_MEMORY_SCOPE_AGENT); }
FI unsigned xb_add(unsigned* p, unsigned v) { return __hip_atomic_fetch_add(p, v, __ATOMIC_RELAXED, __HIP_MEMORY_SCOPE_AGENT); }
FI unsigned xb_xcc_id() { return (unsigned)__builtin_amdgcn_s_getreg((3 << 11) | 20) & 0xFu; }
#define XB_SPIN(cond, bar) do { unsigned _sp = 0; while (cond) { __builtin_amdgcn_s_sleep(1); \
    if ((++_sp & 255u) == 0u) { if (xb_ld(&(bar)[XB_TMO])) break; if (_sp > XB_SPIN_CAP) { atomicAdd(&(bar)[XB_TMO], 1u); break; } } } } while (0)
FI void xcd_barrier_complete(unsigned* bar, unsigned x, unsigned& nloc, unsigned& nx) {
    const unsigned G = gridDim.x;
    unsigned sum, cnt, mine, sp = 0u;
    for (;;) {
        sum = 0u; cnt = 0u; mine = 0u;
#pragma unroll
        for (unsigned j = 0; j < 16; ++j) { const unsigned c = xb_ld(&bar[XB_XCNT(j)]); sum += c; cnt += (c > 0u) ? 1u : 0u; mine = (j == x) ? c : mine; }
        if (sum == G) break;
        __builtin_amdgcn_s_sleep(1);
        if ((++sp & 255u) == 0u) { if (xb_ld(&bar[XB_TMO])) break; if (sp > XB_SPIN_CAP) { atomicAdd(&bar[XB_TMO], 1u); break; } }
    }
    nloc = mine > 0u ? mine : 1u; nx = cnt > 0u ? cnt : 1u;
}
FI void xcd_barrier(unsigned* bar, volatile LAS unsigned* st) {
    asm volatile("s_waitcnt vmcnt(0)" ::: "memory");
    __syncthreads();
    if (tid_l() == 0) {
        const unsigned x = xb_xcc_id();
        __builtin_amdgcn_s_waitcnt(0);
        unsigned nloc = st[0], nx = st[1];
        if (nloc == 0u) { xcd_barrier_complete(bar, x, nloc, nx); st[0] = nloc; st[1] = nx; }
        const unsigned old = xb_add(&bar[XB_XSUB(x)], 1u);
        const unsigned gen = old / nloc;
        if (old + 1u == (gen + 1u) * nloc) {
            __builtin_amdgcn_fence(__ATOMIC_RELEASE, "agent");
            asm volatile("s_waitcnt vmcnt(0)" ::: "memory");
            const unsigned og = xb_add(&bar[XB_TOP], 1u);
            const unsigned tg = og / nx;
            if (og + 1u == (tg + 1u) * nx) xb_add(&bar[XB_TOPGEN], 1u);
            else XB_SPIN(xb_ld(&bar[XB_TOPGEN]) == tg, bar);
            __builtin_amdgcn_fence(__ATOMIC_ACQUIRE, "agent");
            xb_add(&bar[XB_XGEN(x)], 1u);
            asm volatile("s_waitcnt vmcnt(0)" ::: "memory");
        } else {
            XB_SPIN(xb_ld(&bar[XB_XGEN(x)]) == gen, bar);
            __builtin_amdgcn_fence(__ATOMIC_ACQUIRE, "agent");
            asm volatile("s_waitcnt vmcnt(0)" ::: "memory");
        }
    }
    __syncthreads();
}
#define GRID_BAR() do { const Args _ab = load_args(); xcd_barrier((unsigned*)(_ab.ws + OFF_BAR), xst); } while (0)

FI void meta_rows_out(const Args& a) {
    const int tid = tid_l(), lane = tid & 63, w = tid >> 6;
    if (w != 0 || blockIdx.x >= 128) return;
    const bf16_t* A = (const bf16_t*)(a.ws + OFF_MIX) + (size_t)(ROW0 + (lane & 15)) * DMIX + 8 * (lane >> 4);
    const bf16_t* B = (const bf16_t*)(a.ws + OFF_WOUT) + (size_t)(16 * blockIdx.x + (lane & 15)) * DMIX + 8 * (lane >> 4);
    f32x4 acc0 = (f32x4){0.f, 0.f, 0.f, 0.f}, acc1 = acc0;
#pragma unroll 1
    for (int k0 = 0; k0 < DMIX; k0 += 512) {
        bf16x8 av[16], bv[16];
#pragma unroll
        for (int j = 0; j < 16; ++j) { av[j] = *(const bf16x8*)(A + k0 + 32 * j); bv[j] = *(const bf16x8*)(B + k0 + 32 * j); }
#pragma unroll
        for (int j = 0; j < 16; j += 2) { acc0 = mfma16(av[j], bv[j], acc0); acc1 = mfma16(av[j + 1], bv[j + 1], acc1); }
    }
    float* O = (float*)(a.ws + OFF_OUT);
#pragma unroll
    for (int i = 0; i < 4; ++i) O[(size_t)(ROW0 + 4 * (lane >> 4) + i) * DM + 16 * blockIdx.x + (lane & 15)] = acc0[i] + acc1[i];
}

#ifndef PHM
#define PHM 0xffff
#endif
#define DBL 0
#define ATTVAR 0
__global__ void __launch_bounds__(512, 2) fwd(Args a_unused) {
    extern __shared__ __attribute__((aligned(16))) unsigned char lds[];
    cg::grid_group grid = cg::this_grid();
    LAS unsigned char* ldsl = (LAS unsigned char*)lds;
    LAS int* slot = (LAS int*)(ldsl + LDS_BYTES - 16);

    volatile LAS unsigned* xst = (volatile LAS unsigned*)(ldsl + LDS_BYTES - 32);
    if (tid_l() < 2) xst[tid_l()] = 0u;
    __syncthreads();
    if (tid_l() == 0) { const Args a = load_args(); (void)xb_add((unsigned*)(a.ws + OFF_BAR) + XB_XCNT(xb_xcc_id()), 1u); }
    if (PHM & 1) {
        { const Args a = load_args(); rope_tables(a); }
        { const Args a = load_args(); convert_weights(a, 0, lds); }
        if (DBL & 256) { const Args a = load_args(); convert_weights(a, 0, lds); }
        { const Args a = load_args(); convert_pool_w(a, lds); }
        { const Args a = load_args(); row_pass(a, 0, 0); }
    }
    grid.sync();

    for (int layer = 0; layer < 2; ++layer) {
        if (PHM & 2) {
            const Args a = load_args();
            pg8::Gemm g{(const bf16_t*)(a.ws + OFF_U), (const bf16_t*)(a.ws + OFF_WIN), MR, NP, DM};
            pg8::StaticOrder S; S.init(MR, NP, DM, (int)gridDim.x, (int)blockIdx.x);
            Epi1 E{a.ws, a.in[9] + layer * 32};
            pg8::gemm_phase<Epi1, pg8::StaticOrder, true, true>(ldsl, g, S, E);
            if (DBL & 64) { __syncthreads(); pg8::gemm_phase<Epi1, pg8::StaticOrder, true, true>(ldsl, g, S, E); }
        }
        GRID_BAR();
        {
            int nxt = 0;
            for (;;) {
                const Args a = load_args();
                const int it = next_item((unsigned*)(a.ws + OFF_CTL) + layer * 8 + 0, slot, nxt, 0);
                if (it < 260) ssd_s1(a, layer, it >> 2, it & 3, lds);
                else if (it < 260 + IDX_BLOCK_TASKS) indexer_block_task<0>(a, it - 260, lds);
                else if (it < 260 + IDX_BLOCK_TASKS + 264) pool_pre_item(a, it - 260 - IDX_BLOCK_TASKS);
                else break;
            }
#ifdef PROBE_IDX
            nxt = 0;
            for (;;) {
                const Args a = load_args();
                const int it = next_item((unsigned*)(a.ws + OFF_CTL) + layer * 8 + 6, slot, nxt, 0);
                if (it < IDX_BLOCK_TASKS) indexer_block_task<PROBE_IDX>(a, it, lds);
                else break;
            }
#endif
        }
        GRID_BAR();
        if (PHM & 32) {
            const Args a = load_args();
            pg8::Gemm g{(const bf16_t*)(a.ws + OFF_U), (const bf16_t*)(a.ws + OFF_PWT) + (size_t)layer * 4 * 65536, 4 * MR, 256, 256};
            pg8::PoolOrder S{(int)gridDim.x, (int)blockIdx.x};
            EpiPool E{(bf16_t*)(a.ws + OFF_MIX), (const bf16_t*)(a.ws + OFF_PG), a.in[6] + layer * 1024};
            pg8::gemm_phase<EpiPool, pg8::PoolOrder, false, true>(ldsl, g, S, E);
        }
        {
            int nxt = 0;
            for (;;) {
                const Args a = load_args();
                const int it = next_item((unsigned*)(a.ws + OFF_CTL) + layer * 8 + 1, slot, nxt, 0);
                if (it < 128) ssd_scan_item(a, it);
                else break;
            }
            const int lane = tid_l() & 63;
            const int wq = __builtin_amdgcn_readfirstlane(tid_l() >> 6);
            int nv = wave_fetch((unsigned*)(load_args().ws + OFF_CTL + 20480) + ((layer * 3 + 1) * 8 + wq) * 64, lane);
            for (;;) {
                const Args a = load_args();
                const int it = 8 * __builtin_amdgcn_readfirstlane(nv) + wq;
                if (it >= NTOK) break;
                nv = wave_fetch((unsigned*)(a.ws + OFF_CTL + 20480) + ((layer * 3 + 1) * 8 + wq) * 64, lane);
                topk_item(a, it, lds);
            }
        }
        GRID_BAR();
        {
            int nxt = 0;
            for (;;) {
                const Args a = load_args();
                const int it = next_item((unsigned*)(a.ws + OFF_CTL) + layer * 8 + 2, slot, nxt, 0);
                if (it < 260) ssd_s3(a, layer, it >> 2, it & 3, lds);
                else break;
            }
            __syncthreads();
            const int lane = tid_l() & 63;
            const int wq = __builtin_amdgcn_readfirstlane(tid_l() >> 6);
            int nv = wave_fetch((unsigned*)(load_args().ws + OFF_CTL + 20480) + ((layer * 3 + 2) * 8 + wq) * 64, lane);
            for (;;) {
                const Args a = load_args();
                const int it = 8 * __builtin_amdgcn_readfirstlane(nv) + wq;
                if (it >= NTOK * 2) break;
                nv = wave_fetch((unsigned*)(a.ws + OFF_CTL + 20480) + ((layer * 3 + 2) * 8 + wq) * 64, lane);
                attn_item<0>(a, it, lds);
            }
        }
        GRID_BAR();
        if (PHM & 1024) {
            const Args a = load_args();
            const int skip = 256;
            pg8::Gemm g{(const bf16_t*)(a.ws + OFF_MIX) + (size_t)skip * DMIX, (const bf16_t*)(a.ws + OFF_WOUT), MR - skip, DM, DMIX};
            pg8::StaticOrder S; S.init(MR - skip, DM, DMIX, (int)gridDim.x, (int)blockIdx.x);
            EpiOut E{(float*)(a.ws + OFF_OUT), skip};
            pg8::gemm_phase<EpiOut, pg8::StaticOrder, false, true>(ldsl, g, S, E);
            if (DBL & 128) { __syncthreads(); pg8::gemm_phase<EpiOut, pg8::StaticOrder, false, true>(ldsl, g, S, E); }
            if (layer == 0) meta_rows_out(a);
        }
        GRID_BAR();
        if (PHM & 2048) {
            if (layer == 0) { { const Args a = load_args(); row_pass(a, 1, 0); } { const Args a = load_args(); convert_weights(a, 1, lds); } }
            else { const Args a = load_args(); row_pass(a, 2, 1); }
        }
        if (layer == 0) GRID_BAR();
    }
}

extern "C" void kernel_launch(void* const* d_in, const int* in_sizes, int n_in, void* d_out, int out_size, void* d_ws, size_t ws_size, hipStream_t stream) {
    static int grid = 0;
    if (grid == 0) {
        int dev = 0, cus = 0, per_cu = 0;
        (void)hipGetDevice(&dev); (void)hipDeviceGetAttribute(&cus, hipDeviceAttributeMultiprocessorCount, dev);
        (void)hipFuncSetAttribute((const void*)fwd, hipFuncAttributeMaxDynamicSharedMemorySize, LDS_BYTES);
        (void)hipOccupancyMaxActiveBlocksPerMultiprocessor(&per_cu, (const void*)fwd, 512, LDS_BYTES);
        if (ws_size < WS_END || n_in != 14) { fprintf(stderr, "kernel_launch: ws_size %zu < %zu or n_in %d != 14\n", ws_size, (size_t)WS_END, n_in); grid = -1; return; }
        grid = cus > 0 ? cus : 256;
        (void)per_cu;
    }
    if (grid < 0) return;
    (void)hipMemsetAsync((char*)d_ws + OFF_CTL, 0, CTL_BYTES, stream);
    Args a{};
    for (int i = 0; i < 14; ++i) a.in[i] = (const float*)d_in[i];
    a.out = (float*)d_out; a.ws = (unsigned char*)d_ws;
    void* args[] = {&a};
    hipError_t e = hipLaunchCooperativeKernel((void*)fwd, dim3(grid), dim3(512), args, LDS_BYTES, stream);
    if (e != hipSuccess) fprintf(stderr, "cooperative launch failed: %s (grid %d)\n", hipGetErrorString(e), grid);
}
```
